# Optimizing an MI355X kernel written in HIP

```python
import math
import numpy as np
import jax, jax.numpy as jnp
from jax import lax

D_MODEL = 1024
BATCH = 8
SEQ = 2048
DEPTH = 4

CHUNK = 64
N_MEM = 256
RMS_EPS = 1e-6
S5_WIDTH = D_MODEL // 2
S5_GROUP = 16
S5_GROUPS = S5_WIDTH // S5_GROUP
S5_STATE = 64
S5_DT_MIN = 0.001
S5_DT_MAX = 0.1
GDN_HEAD_DIM = 128
GDN_WIDTH = D_MODEL // 2
GDN_HEADS = GDN_WIDTH // GDN_HEAD_DIM
GDN_CONV = 4
GDN_DT_MIN = 0.001
GDN_DT_MAX = 0.1
AB_IN = S5_WIDTH + 4 * GDN_WIDTH + 2 * GDN_HEADS
CA_HEADS = 16
CA_HEAD_DIM = D_MODEL // CA_HEADS
CA_LEFT_CHUNKS = 8
CA_BAND = (CA_LEFT_CHUNKS + 1) * CHUNK
MAX_REL_DIST = 128
XA_HEADS = 4
XA_HEAD_DIM = D_MODEL // XA_HEADS
FFN_HIDDEN = -(-8 * D_MODEL // (3 * 256)) * 256
N_EVEN = (DEPTH + 1) // 2
N_ODD = DEPTH // 2

kernel_name = "hybrid_s5_deltanet_chunkattn_encoder"

F32 = jnp.float32


def rms_norm(x, g):
    x32 = x.astype(F32)
    y = x32 * lax.rsqrt(jnp.mean(x32 * x32, axis=-1, keepdims=True) + RMS_EPS)
    return (y * g.astype(F32)).astype(x.dtype)


def l2_norm(t):
    return t * lax.rsqrt(jnp.sum(t * t, axis=-1, keepdims=True) + RMS_EPS)


def s5_mixer(u, a_re, a_im, log_dt, b_re, b_im, c_re, c_im, d, w_glu, b_glu):
    bsz, seq, _ = u.shape
    u32 = u.astype(F32).reshape(bsz, seq, S5_GROUPS, S5_GROUP)
    lam = lax.complex(a_re.astype(F32), a_im.astype(F32))
    dt = jnp.exp(log_dt.astype(F32))[:, None]
    lam_bar = jnp.exp(lam * dt)
    b_bar = ((lam_bar - 1.0) / lam)[:, :, None] * lax.complex(b_re.astype(F32), b_im.astype(F32))
    c = lax.complex(c_re.astype(F32), c_im.astype(F32))
    bu = jnp.einsum('bsgc,gpc->bsgp', u32.astype(jnp.complex64), b_bar)
    lam_seq = jnp.broadcast_to(lam_bar, bu.shape)

    def combine(e_prev, e_next):
        a_p, s_p = e_prev
        a_n, s_n = e_next
        return a_n * a_p, a_n * s_p + s_n

    _, states = lax.associative_scan(combine, (lam_seq, bu), axis=1)
    y = jnp.real(jnp.einsum('bsgp,gcp->bsgc', states, c)) + d.astype(F32) * u32
    h = jax.nn.gelu(y.reshape(bsz, seq, S5_WIDTH))
    out = h * jax.nn.sigmoid(h @ w_glu.astype(F32) + b_glu.astype(F32))
    return out.astype(u.dtype)


def gated_deltanet(q, k, v, gate, a_logit, b_logit, conv_w, a_log, dt_bias, out_g):
    bsz, seq, _ = q.shape
    n = seq // CHUNK
    qkv = jnp.concatenate([q, k, v], axis=-1).astype(F32)
    qkv = lax.conv_general_dilated(
        qkv, conv_w.astype(F32)[:, None, :], window_strides=(1,),
        padding=[(GDN_CONV - 1, 0)], dimension_numbers=('NWC', 'WIO', 'NWC'),
        feature_group_count=3 * GDN_WIDTH)
    qkv = jax.nn.silu(qkv)
    q, k, v = jnp.split(qkv, 3, axis=-1)

    def heads(t):
        return t.reshape(bsz, n, CHUNK, GDN_HEADS, GDN_HEAD_DIM).transpose(0, 3, 1, 2, 4)

    def per_head(t):
        return t.reshape(bsz, n, CHUNK, GDN_HEADS).transpose(0, 3, 1, 2)

    q = l2_norm(heads(q)) * (GDN_HEAD_DIM ** -0.5)
    k = l2_norm(heads(k))
    v = heads(v)
    beta = per_head(jax.nn.sigmoid(b_logit.astype(F32)))
    g = -jnp.exp(a_log.astype(F32)) * jax.nn.softplus(a_logit.astype(F32) + dt_bias.astype(F32))
    gcum = jnp.cumsum(per_head(g), axis=-1)
    gamma = jnp.exp(gcum)
    diff = gcum[..., :, None] - gcum[..., None, :]
    idx = jnp.arange(CHUNK)
    strict = idx[:, None] > idx[None, :]
    causal = idx[:, None] >= idx[None, :]
    decay_strict = jnp.where(strict, jnp.exp(jnp.where(strict, diff, 0.0)), 0.0)
    decay_causal = jnp.where(causal, jnp.exp(jnp.where(causal, diff, 0.0)), 0.0)
    kk = jnp.einsum('bhntd,bhnjd->bhntj', k, k)
    lower = jnp.eye(CHUNK, dtype=F32) + beta[..., :, None] * kk * decay_strict
    rhs = jnp.concatenate([beta[..., None] * v, (beta * gamma)[..., None] * k], axis=-1)
    sol = lax.linalg.triangular_solve(lower, rhs, left_side=True, lower=True, unit_diagonal=True)
    u_new, w_k = jnp.split(sol, [GDN_HEAD_DIM], axis=-1)
    qk = jnp.einsum('bhntd,bhnjd->bhntj', q, k) * decay_causal
    q_g = q * gamma[..., None]
    k_tail = k * jnp.exp(gcum[..., -1:] - gcum)[..., None]
    chunk_decay = jnp.exp(gcum[..., -1])

    def step(state, inp):
        u_c, wk_c, qk_c, qg_c, kt_c, dec_c = inp
        w = u_c - jnp.einsum('bhtd,bhde->bhte', wk_c, state)
        o = jnp.einsum('bhtd,bhde->bhte', qg_c, state) + jnp.einsum('bhtj,bhje->bhte', qk_c, w)
        state = dec_c[..., None, None] * state + jnp.einsum('bhtd,bhte->bhde', kt_c, w)
        return state, o

    state0 = jnp.zeros((bsz, GDN_HEADS, GDN_HEAD_DIM, GDN_HEAD_DIM), F32)
    xs = (jnp.moveaxis(u_new, 2, 0), jnp.moveaxis(w_k, 2, 0), jnp.moveaxis(qk, 2, 0),
          jnp.moveaxis(q_g, 2, 0), jnp.moveaxis(k_tail, 2, 0), jnp.moveaxis(chunk_decay, 2, 0))
    _, o = lax.scan(step, state0, xs)
    o = o.transpose(1, 0, 3, 2, 4).reshape(bsz, seq, GDN_HEADS, GDN_HEAD_DIM)
    o = rms_norm(o, out_g) * jax.nn.silu(gate.astype(F32).reshape(bsz, seq, GDN_HEADS, GDN_HEAD_DIM))
    return o.reshape(bsz, seq, GDN_WIDTH).astype(gate.dtype)


def chunk_attention(h, w_qkv, w_out, q_g, k_g, rel_bias):
    bsz, seq, _ = h.shape
    n = seq // CHUNK
    qkv = (h @ w_qkv).reshape(bsz, seq, 3, CA_HEADS, CA_HEAD_DIM)
    q = rms_norm(qkv[:, :, 0], q_g).astype(F32)
    k = rms_norm(qkv[:, :, 1], k_g).astype(F32)
    v = qkv[:, :, 2].astype(F32)
    pad = CA_LEFT_CHUNKS * CHUNK
    k_pad = jnp.pad(k, ((0, 0), (pad, 0), (0, 0), (0, 0)))
    v_pad = jnp.pad(v, ((0, 0), (pad, 0), (0, 0), (0, 0)))
    rel = np.arange(CHUNK)[:, None] - np.arange(CA_BAND)[None, :] + pad
    rel_idx = np.clip(rel, -MAX_REL_DIST, MAX_REL_DIST) + MAX_REL_DIST
    bias = rel_bias.astype(F32)[:, rel_idx]
    band_pos = jnp.arange(CA_BAND) - pad
    scale = CA_HEAD_DIM ** -0.5

    def one_chunk(c):
        start = c * CHUNK
        q_c = lax.dynamic_slice_in_dim(q, start, CHUNK, axis=1)
        k_c = lax.dynamic_slice_in_dim(k_pad, start, CA_BAND, axis=1)
        v_c = lax.dynamic_slice_in_dim(v_pad, start, CA_BAND, axis=1)
        s = jnp.einsum('bqhd,bkhd->bhqk', q_c, k_c) * scale + bias
        s = jnp.where((band_pos + start) >= 0, s, -1e30)
        p = jax.nn.softmax(s, axis=-1)
        return jnp.einsum('bhqk,bkhd->bqhd', p, v_c)

    o = lax.map(one_chunk, jnp.arange(n))
    o = o.transpose(1, 0, 2, 3, 4).reshape(bsz, seq, D_MODEL).astype(h.dtype)
    return o @ w_out


def memory_cross_attention(h, mem_n, w_q, w_kv, w_out, q_g, k_g):
    bsz, seq, _ = h.shape
    n_mem = mem_n.shape[1]
    q = rms_norm((h @ w_q).reshape(bsz, seq, XA_HEADS, XA_HEAD_DIM), q_g).astype(F32)
    kv = (mem_n @ w_kv).reshape(bsz, n_mem, 2, XA_HEADS, XA_HEAD_DIM)
    k = rms_norm(kv[:, :, 0], k_g).astype(F32)
    v = kv[:, :, 1].astype(F32)
    s = jnp.einsum('bqhd,bkhd->bhqk', q, k) * (XA_HEAD_DIM ** -0.5)
    p = jax.nn.softmax(s, axis=-1)
    o = jnp.einsum('bhqk,bkhd->bqhd', p, v).reshape(bsz, seq, D_MODEL).astype(h.dtype)
    return o @ w_out


def swiglu(h, w_gate, w_up, w_down):
    return (jax.nn.silu(h @ w_gate) * (h @ w_up)) @ w_down


def setup_inputs(seed: int = 0) -> dict:
    key = jax.random.key(seed)
    keys = jax.random.split(key, 64)
    counter = iter(range(64))

    def nk():
        return keys[next(counter)]

    def nrm(shape, scale):
        return scale * jax.random.normal(nk(), shape, F32)

    def gain(shape):
        return 1.0 + nrm(shape, 0.02)

    D, NE, NO = D_MODEL, N_EVEN, N_ODD
    G, P, CG = S5_GROUPS, S5_STATE, S5_GROUP
    x = nrm((BATCH, SEQ, D), 1.0)
    mem = nrm((BATCH, N_MEM, D), 1.0)
    ab_norm_g = gain((NE, D))
    ab_w_in = nrm((NE, D, AB_IN), D ** -0.5)
    ab_w_out = nrm((NE, S5_WIDTH + GDN_WIDTH, D), (S5_WIDTH + GDN_WIDTH) ** -0.5)
    s5_a_re = -0.5 + nrm((NE, G, P), 0.01)
    s5_a_im = math.pi * jnp.arange(P, dtype=F32) + nrm((NE, G, P), 0.01)
    s5_log_dt = jax.random.uniform(nk(), (NE, G), F32, math.log(S5_DT_MIN), math.log(S5_DT_MAX))
    s5_b_re = nrm((NE, G, P, CG), (2 * CG) ** -0.5)
    s5_b_im = nrm((NE, G, P, CG), (2 * CG) ** -0.5)
    s5_c_re = nrm((NE, G, CG, P), (2 * P) ** -0.5)
    s5_c_im = nrm((NE, G, CG, P), (2 * P) ** -0.5)
    s5_d = nrm((NE, G, CG), 1.0)
    s5_w_glu = nrm((NE, S5_WIDTH, S5_WIDTH), S5_WIDTH ** -0.5)
    s5_b_glu = nrm((NE, S5_WIDTH), 0.01)
    gdn_conv_w = nrm((NE, GDN_CONV, 3 * GDN_WIDTH), GDN_CONV ** -0.5)
    gdn_a_log = jnp.log(jax.random.uniform(nk(), (NE, GDN_HEADS), F32, 1.0, 16.0))
    gdn_dt = jnp.exp(jax.random.uniform(nk(), (NE, GDN_HEADS), F32, math.log(GDN_DT_MIN), math.log(GDN_DT_MAX)))
    gdn_dt_bias = gdn_dt + jnp.log(-jnp.expm1(-gdn_dt))
    gdn_out_norm_g = gain((NE, GDN_HEAD_DIM))
    c_norm_g = gain((NO, D))
    c_w_qkv = nrm((NO, D, 3 * D), D ** -0.5)
    c_w_out = nrm((NO, D, D), D ** -0.5)
    c_q_norm_g = gain((NO, CA_HEAD_DIM))
    c_k_norm_g = gain((NO, CA_HEAD_DIM))
    c_rel_bias = nrm((NO, CA_HEADS, 2 * MAX_REL_DIST + 1), 0.1)
    mem_norm_g = gain((D,))
    xa_norm_g = gain((DEPTH, D))
    xa_w_q = nrm((DEPTH, D, D), D ** -0.5)
    xa_w_kv = nrm((DEPTH, D, 2 * D), D ** -0.5)
    xa_w_out = nrm((DEPTH, D, D), D ** -0.5)
    xa_q_norm_g = gain((DEPTH, XA_HEAD_DIM))
    xa_k_norm_g = gain((DEPTH, XA_HEAD_DIM))
    f_norm_g = gain((DEPTH, D))
    f_w_gate = nrm((DEPTH, D, FFN_HIDDEN), D ** -0.5)
    f_w_up = nrm((DEPTH, D, FFN_HIDDEN), D ** -0.5)
    f_w_down = nrm((DEPTH, FFN_HIDDEN, D), FFN_HIDDEN ** -0.5)
    return {
        "x": x, "mem": mem,
        "ab_norm_g": ab_norm_g, "ab_w_in": ab_w_in, "ab_w_out": ab_w_out,
        "s5_a_re": s5_a_re, "s5_a_im": s5_a_im, "s5_log_dt": s5_log_dt,
        "s5_b_re": s5_b_re, "s5_b_im": s5_b_im, "s5_c_re": s5_c_re, "s5_c_im": s5_c_im,
        "s5_d": s5_d, "s5_w_glu": s5_w_glu, "s5_b_glu": s5_b_glu,
        "gdn_conv_w": gdn_conv_w, "gdn_a_log": gdn_a_log, "gdn_dt_bias": gdn_dt_bias,
        "gdn_out_norm_g": gdn_out_norm_g,
        "c_norm_g": c_norm_g, "c_w_qkv": c_w_qkv, "c_w_out": c_w_out,
        "c_q_norm_g": c_q_norm_g, "c_k_norm_g": c_k_norm_g, "c_rel_bias": c_rel_bias,
        "mem_norm_g": mem_norm_g, "xa_norm_g": xa_norm_g, "xa_w_q": xa_w_q,
        "xa_w_kv": xa_w_kv, "xa_w_out": xa_w_out, "xa_q_norm_g": xa_q_norm_g,
        "xa_k_norm_g": xa_k_norm_g,
        "f_norm_g": f_norm_g, "f_w_gate": f_w_gate, "f_w_up": f_w_up, "f_w_down": f_w_down,
    }


def reference(x, mem, ab_norm_g, ab_w_in, ab_w_out, s5_a_re, s5_a_im, s5_log_dt,
              s5_b_re, s5_b_im, s5_c_re, s5_c_im, s5_d, s5_w_glu, s5_b_glu,
              gdn_conv_w, gdn_a_log, gdn_dt_bias, gdn_out_norm_g,
              c_norm_g, c_w_qkv, c_w_out, c_q_norm_g, c_k_norm_g, c_rel_bias,
              mem_norm_g, xa_norm_g, xa_w_q, xa_w_kv, xa_w_out, xa_q_norm_g, xa_k_norm_g,
              f_norm_g, f_w_gate, f_w_up, f_w_down):
    split_points = [S5_WIDTH, S5_WIDTH + GDN_WIDTH, S5_WIDTH + 2 * GDN_WIDTH,
                    S5_WIDTH + 3 * GDN_WIDTH, S5_WIDTH + 4 * GDN_WIDTH,
                    S5_WIDTH + 4 * GDN_WIDTH + GDN_HEADS]
    mem_n = rms_norm(mem, mem_norm_g)
    for layer in range(DEPTH):
        i = layer // 2
        if layer % 2 == 0:
            h = rms_norm(x, ab_norm_g[i])
            proj = h @ ab_w_in[i]
            u, q, k, v, gate, a_logit, b_logit = jnp.split(proj, split_points, axis=-1)
            a_out = s5_mixer(u, s5_a_re[i], s5_a_im[i], s5_log_dt[i], s5_b_re[i], s5_b_im[i],
                             s5_c_re[i], s5_c_im[i], s5_d[i], s5_w_glu[i], s5_b_glu[i])
            b_out = gated_deltanet(q, k, v, gate, a_logit, b_logit, gdn_conv_w[i],
                                   gdn_a_log[i], gdn_dt_bias[i], gdn_out_norm_g[i])
            x = x + jnp.concatenate([a_out, b_out], axis=-1) @ ab_w_out[i]
        else:
            x = x + chunk_attention(rms_norm(x, c_norm_g[i]), c_w_qkv[i], c_w_out[i],
                                    c_q_norm_g[i], c_k_norm_g[i], c_rel_bias[i])
        x = x + memory_cross_attention(rms_norm(x, xa_norm_g[layer]), mem_n, xa_w_q[layer],
                                       xa_w_kv[layer], xa_w_out[layer],
                                       xa_q_norm_g[layer], xa_k_norm_g[layer])
        x = x + swiglu(rms_norm(x, f_norm_g[layer]), f_w_gate[layer], f_w_up[layer], f_w_down[layer])
    return x
```

```cpp
#include <hip/hip_runtime.h>
#include <hip/hip_cooperative_groups.h>
#include <cstdio>
#include <cstdint>
namespace cg = cooperative_groups;

#define DBG_NAIVE 0
#define DBG_NAIVE_GEMM 0
#define DBG_CHECK 0
#define DBG_SKIP 0
#define DBG_DOUBLE 0
#define DBG_A 1.0f
#define DBG_HALF 0
#ifndef MK_ONE_LAUNCH
#define MK_ONE_LAUNCH 1
#endif

#define LAS __attribute__((address_space(3)))
#define DI __device__ __forceinline__
typedef unsigned short bf16_t;
typedef short bf16x8 __attribute__((ext_vector_type(8)));
typedef float f32x4 __attribute__((ext_vector_type(4)));
typedef float f32x2 __attribute__((ext_vector_type(2)));
typedef float f32x16 __attribute__((ext_vector_type(16)));
typedef unsigned u32x4 __attribute__((ext_vector_type(4)));
typedef unsigned u32x2 __attribute__((ext_vector_type(2)));

constexpr int D = 1024, BATCH = 8, SEQ = 2048, M = BATCH * SEQ, NMEM = 256, MMEM = BATCH * NMEM;
constexpr int ABIN = 2568, ABPAD = 2816, FF = 2816;
constexpr float EPS = 1e-6f;
constexpr int S5L = 32, S5NCH = SEQ / S5L, S5ROWS = BATCH * S5NCH  , S5K = 640;
constexpr int NTHR = 512, NWAVES = 8;
constexpr int LDS_BYTES = 147456;

constexpr size_t MiB = 1u << 20;
constexpr size_t WS_SS = 65536;
constexpr size_t WS_PS = 31 * MiB;
constexpr size_t WS_WL = 1 * MiB;
constexpr size_t WL_IN = 0, WL_OUT = 6 * MiB, WL_GLU = 8 * MiB, WL_XQ = 9 * MiB, WL_XO = 11 * MiB, WL_GU = 13 * MiB, WL_DN = 24 * MiB;
constexpr size_t WL_V = 4 * MiB;
constexpr size_t WS_KALL = 33 * MiB, WS_VTALL = 49 * MiB, WS_MEMN = 65 * MiB, WS_HN = 69 * MiB, WS_MIX = 101 * MiB, WS_BIG = 133 * MiB, WS_LOG = 229 * MiB, WS_SCR = 230 * MiB, WS_END = 330 * MiB;
constexpr size_t SC_UG = 0, SC_T = 20 * MiB, SC_BM = 40 * MiB, SC_S = 48 * MiB;
constexpr size_t SC_WKV = 64 * MiB;
constexpr size_t SC_UT = 56 * MiB, SC_QG = 72 * MiB, SC_QK = 88 * MiB, SC_DEC = 96 * MiB;
constexpr size_t HN_WK = 0, HN_KT = 16 * MiB;

typedef __bf16 bf16x2_t __attribute__((ext_vector_type(2)));
DI unsigned cvt_pk_bf16(float lo, float hi) { const f32x2 v = {lo, hi}; const bf16x2_t b = __builtin_convertvector(v, bf16x2_t); return __builtin_bit_cast(unsigned, b); }
DI float bf2f(unsigned short b) { return __builtin_bit_cast(float, (unsigned)b << 16); }
DI float bflo(unsigned w) { return __builtin_bit_cast(float, w << 16); }
DI float bfhi(unsigned w) { return __builtin_bit_cast(float, w & 0xffff0000u); }
DI unsigned short f2bf(float f) { return (unsigned short)(cvt_pk_bf16(f, 0.f) & 0xffffu); }
DI float wave_sum(float v) {
#pragma unroll
    for (int o = 1; o < 64; o <<= 1) v += __shfl_xor(v, o);
    return v;
}
DI float sigmoidf_(float x) { return 1.f / (1.f + __expf(-x)); }
DI float siluf_(float x) { return x / (1.f + __expf(-x)); }
DI float gelu_tanh(float x) { const float z = 0.7978845608028654f * (x + 0.044715f * x * x * x); return x / (1.f + __expf(-2.f * z)); }
DI u32x4 pack8(const f32x4 a, const f32x4 b) { u32x4 w; w.x = cvt_pk_bf16(a[0], a[1]); w.y = cvt_pk_bf16(a[2], a[3]); w.z = cvt_pk_bf16(b[0], b[1]); w.w = cvt_pk_bf16(b[2], b[3]); return w; }
DI void unpack8(const u32x4 w, float* o) { o[0] = bflo(w.x); o[1] = bfhi(w.x); o[2] = bflo(w.y); o[3] = bfhi(w.y); o[4] = bflo(w.z); o[5] = bfhi(w.z); o[6] = bflo(w.w); o[7] = bfhi(w.w); }

DI float rstd_of(const float* ps, int row) {
    const f32x4 a = *(const f32x4*)(ps + (size_t)row * 4);
    return rsqrtf(((a[0] + a[1]) + (a[2] + a[3])) * (1.f / D) + EPS);
}
namespace pg8 {
constexpr int BM = 256, BK = 64, HALF = 128, HTB = HALF * BK * 2;
DI int lds_byte(int r, int c) { const int st = (r >> 4) * 2 + (c >> 5), rr = r & 15, cc = c & 31, ob = rr * 64 + cc * 2; return st * 1024 + (ob ^ (((ob >> 9) & 1) << 5)); }
DI void stage_rc(int b, int& R, int& C) { const int st = b / 1024, sb = b % 1024, swz = sb ^ (((sb >> 9) & 1) << 5); R = (st >> 1) * 16 + swz / 64; C = (st & 1) * 32 + (swz % 64) / 2; }
DI int perm32(int rho) { const int n = rho >> 4, i = rho & 15; return 8 * (i >> 2) + 4 * n + (i & 3); }

struct Unit { int z, pm, pn; };
struct Gemm { const bf16_t* A; const bf16_t* Bt; int lda, ldb, K; long sAz, sBz; };
struct Order {
    int nM, nN, nZ, G, c;
    DI bool next(int i, Unit& u) const {
        const long L = (long)i * G + c; const int per = nM * nN;
        if (c < 0 || L >= (long)per * nZ) return false;
        u.z = (int)(L / per); int wgid = (int)(L % per);
        if ((per & 63) == 0) {
            const int q = per >> 3, xcd = wgid & 7, off = wgid >> 3; wgid = xcd * q + off;
            const int nig = 8 * nN, gid = wgid / nig, fm = gid * 8, rem = nM - fm, gsz = rem < 8 ? rem : 8, wi = wgid % nig;
            u.pm = fm + wi % gsz; u.pn = wi / gsz;
        } else { u.pm = wgid / nN; u.pn = wgid % nN; }
        return true;
    }
};
typedef f32x4 Acc[2][2][4][2];

template <class Epi>
DI void gemm_phase_naive(const Gemm g, const Order& S, const Epi& E) {
    int tid_ = threadIdx.x; asm volatile("" : "+v"(tid_));
    const int tid = tid_, wid = tid >> 6, lane = tid & 63, wr = wid >> 2, wc = wid & 3, fr = lane & 15, fq = lane >> 4;
    Unit cur;
    for (int ui = 0; S.next(ui, cur); ++ui) {
        const bf16_t* Ab = g.A + (size_t)cur.z * g.sAz; const bf16_t* Bb = g.Bt + (size_t)cur.z * g.sBz;
        for (int am = 0; am < 8; ++am) {
            const int ai = am >> 2, m = am & 3;
            const int row = cur.pm * 256 + ai * 128 + wr * 64 + m * 16 + fr;
            float s[2][8];
            for (int bj = 0; bj < 2; ++bj) {
#pragma unroll
                for (int q = 0; q < 8; ++q) s[bj][q] = 0.f;
                const int col0 = cur.pn * 256 + bj * 128 + wc * 32 + 8 * fq;
                for (int k = 0; k < g.K; k += 8) {
                    float av[8]; unpack8(*(const u32x4*)(Ab + (size_t)row * g.lda + k), av);
#pragma unroll
                    for (int q = 0; q < 8; ++q) { float bv[8]; unpack8(*(const u32x4*)(Bb + (size_t)(col0 + q) * g.ldb + k), bv);
#pragma unroll
                        for (int e = 0; e < 8; ++e) s[bj][q] += av[e] * bv[e]; }
                }
            }
            E.naive(cur, row, wc, fq, (f32x4){s[0][0], s[0][1], s[0][2], s[0][3]}, (f32x4){s[0][4], s[0][5], s[0][6], s[0][7]}, (f32x4){s[1][0], s[1][1], s[1][2], s[1][3]}, (f32x4){s[1][4], s[1][5], s[1][6], s[1][7]});
        }
    }
}
template <class Epi, bool ALIGN_EPI>
DI void gemm_phase(LAS unsigned char* lds, const Gemm g, const Order& S, const Epi& E) {
#if DBG_NAIVE_GEMM
    gemm_phase_naive<Epi>(g, S, E); return;
#endif
    int tid_ = threadIdx.x; asm volatile("" : "+v"(tid_));
    const int tid = tid_, wid = __builtin_amdgcn_readfirstlane(tid >> 6), lane = tid & 63, wr = wid >> 2, wc = wid & 3, fr = lane & 15, fq = lane >> 4;
    const int K = g.K, nt = K / BK;
    unsigned voffA[2], voffB[2];
#pragma unroll
    for (int i = 0; i < 2; ++i) { int R, C; stage_rc(tid * 16 + i * 8192, R, C); const int Rb = (R & ~31) + perm32(R & 31);
        voffA[i] = (unsigned)(R * g.lda + C) * 2u; voffB[i] = (unsigned)(Rb * g.ldb + C) * 2u; }
    const size_t kstep = (size_t)(BK * 2);
    const size_t hA = (size_t)HALF * g.lda * 2, hB = (size_t)HALF * g.ldb * 2;
    const unsigned ldsw = (unsigned)wid * 1024u;
    const int aoff = lds_byte(wr * 64 + fr, fq * 8), boff = lds_byte(wc * 32 + fr, fq * 8);
#define PG8_SA(b, h) (((b) * 2 + (h)) * HTB)
#define PG8_SB(b, h) ((4 + (b) * 2 + (h)) * HTB)
#define PG8_STAGE(bufoff, gbase, voff) do { _Pragma("unroll") for (int _i = 0; _i < 2; ++_i) \
        __builtin_amdgcn_global_load_lds((const unsigned*)((const char*)(gbase) + (voff)[_i]), (LAS unsigned*)(lds + (bufoff) + ldsw + _i * 8192), 16, 0, 0); } while (0)
#define PG8_LDA(dst, b, h) do { _Pragma("unroll") for (int m = 0; m < 4; ++m) _Pragma("unroll") for (int k = 0; k < 2; ++k) dst[m][k] = *(const LAS bf16x8*)(lds + PG8_SA(b, h) + aoff + m * 2048 + k * 1024); } while (0)
#define PG8_LDB(dst, b, h) do { _Pragma("unroll") for (int n = 0; n < 2; ++n) _Pragma("unroll") for (int k = 0; k < 2; ++k) dst[n][k] = *(const LAS bf16x8*)(lds + PG8_SB(b, h) + boff + n * 2048 + k * 1024); } while (0)
#define PG8_MMA(ai, bj, At, Bt) do { __builtin_amdgcn_s_setprio(1); _Pragma("unroll") for (int m = 0; m < 4; ++m) _Pragma("unroll") for (int n = 0; n < 2; ++n) _Pragma("unroll") for (int k = 0; k < 2; ++k) \
        acc[ai][bj][m][n] = __builtin_amdgcn_mfma_f32_16x16x32_bf16(Bt[n][k], At[m][k], acc[ai][bj][m][n], 0, 0, 0); __builtin_amdgcn_s_setprio(0); } while (0)
#define PG8_WAIT_V(n) asm volatile("s_waitcnt vmcnt(" #n ")" ::: "memory")
#define PG8_WAIT_L(n) asm volatile("s_waitcnt lgkmcnt(" #n ")" ::: "memory")
#define PG8_BAR __builtin_amdgcn_s_barrier()
#define PG8_SCHED __builtin_amdgcn_sched_barrier(0)
    Unit cur, nxt; int ui = 0;
    if (!S.next(0, cur)) return;
    Acc acc;
#pragma unroll
    for (int a = 0; a < 2; ++a)
#pragma unroll
        for (int b = 0; b < 2; ++b)
#pragma unroll
            for (int m = 0; m < 4; ++m)
#pragma unroll
                for (int n = 0; n < 2; ++n) acc[a][b][m][n] = (f32x4){0.f, 0.f, 0.f, 0.f};
    bf16x8 At[4][2], B0[2][2], B1[2][2];
    const char* cA = (const char*)g.A + ((size_t)cur.z * g.sAz + (size_t)cur.pm * BM * g.lda) * 2;
    const char* cB = (const char*)g.Bt + ((size_t)cur.z * g.sBz + (size_t)cur.pn * BM * g.ldb) * 2;
    PG8_STAGE(PG8_SB(0, 0), cB, voffB); PG8_STAGE(PG8_SB(0, 1), cB + hB, voffB); PG8_STAGE(PG8_SA(0, 0), cA, voffA); PG8_STAGE(PG8_SA(0, 1), cA + hA, voffA);
    if (wr == 1) PG8_BAR;
    PG8_WAIT_V(2); PG8_BAR;
    PG8_STAGE(PG8_SB(1, 0), cB + kstep, voffB); PG8_STAGE(PG8_SA(1, 0), cA + kstep, voffA); PG8_STAGE(PG8_SB(1, 1), cB + hB + kstep, voffB);
    PG8_WAIT_V(6); PG8_BAR;
    for (;;) {
        const bool has_next = S.next(ui + 1, nxt);
        const char* nA = has_next ? (const char*)g.A + ((size_t)nxt.z * g.sAz + (size_t)nxt.pm * BM * g.lda) * 2 : cA;
        const char* nB = has_next ? (const char*)g.Bt + ((size_t)nxt.z * g.sBz + (size_t)nxt.pn * BM * g.ldb) * 2 : cB;
        for (int t = 0; t < nt; t += 2) {
            const bool last = (t == nt - 2);
            const char* a1 = cA + (size_t)(t + 1) * kstep;
            const char* a2 = last ? nA : cA + (size_t)(t + 2) * kstep; const char* b2 = last ? nB : cB + (size_t)(t + 2) * kstep;
            const char* a3 = a2 + kstep; const char* b3 = b2 + kstep;
            PG8_LDB(B0, 0, 0); PG8_LDB(B1, 0, 1); PG8_SCHED; PG8_LDA(At, 0, 0); PG8_STAGE(PG8_SA(1, 1), a1 + hA, voffA);
            PG8_WAIT_V(8); PG8_WAIT_L(0); PG8_BAR; PG8_MMA(0, 0, At, B0); PG8_MMA(0, 1, At, B1); PG8_BAR; PG8_SCHED;
            PG8_LDA(At, 0, 1); PG8_STAGE(PG8_SB(0, 0), b2, voffB); PG8_STAGE(PG8_SB(0, 1), b2 + hB, voffB); PG8_STAGE(PG8_SA(0, 0), a2, voffA);
            PG8_WAIT_V(8); PG8_WAIT_L(0); PG8_BAR; PG8_MMA(1, 0, At, B0); PG8_MMA(1, 1, At, B1); PG8_BAR; PG8_SCHED;
            PG8_LDB(B0, 1, 0); PG8_LDB(B1, 1, 1); PG8_SCHED; PG8_LDA(At, 1, 0); PG8_STAGE(PG8_SA(0, 1), a2 + hA, voffA);
            PG8_WAIT_V(8); PG8_WAIT_L(0); PG8_BAR; PG8_MMA(0, 0, At, B0); PG8_MMA(0, 1, At, B1); PG8_BAR; PG8_SCHED;
            PG8_LDA(At, 1, 1); PG8_STAGE(PG8_SB(1, 0), b3, voffB); PG8_STAGE(PG8_SB(1, 1), b3 + hB, voffB); PG8_STAGE(PG8_SA(1, 0), a3, voffA);
            PG8_WAIT_V(8); PG8_WAIT_L(0); PG8_BAR; PG8_MMA(1, 0, At, B0); PG8_MMA(1, 1, At, B1); PG8_BAR; PG8_SCHED;
        }
        if constexpr (ALIGN_EPI) { if (wr == 0) PG8_BAR; }
        E(acc, cur, wr, wc, fr, fq);
        if (!has_next) break;
#pragma unroll
        for (int a = 0; a < 2; ++a)
#pragma unroll
            for (int b = 0; b < 2; ++b)
#pragma unroll
                for (int m = 0; m < 4; ++m)
#pragma unroll
                    for (int n = 0; n < 2; ++n) acc[a][b][m][n] = (f32x4){0.f, 0.f, 0.f, 0.f};
        cur = nxt; cA = nA; cB = nB; ++ui;
        if constexpr (ALIGN_EPI) { if (wr == 1) PG8_BAR; }
    }
    PG8_WAIT_V(0);
    if constexpr (!ALIGN_EPI) { if (wr == 0) PG8_BAR; }
    PG8_BAR;
#undef PG8_SA
#undef PG8_SB
#undef PG8_STAGE
#undef PG8_LDA
#undef PG8_LDB
#undef PG8_MMA
#undef PG8_WAIT_V
#undef PG8_WAIT_L
#undef PG8_BAR
#undef PG8_SCHED
}

template <class E> DI void epi_rows_scaled(const E& e, const float* rs, const Acc& acc, const Unit& u, int wr, int wc, int fr, int fq) {
    float r[2][4];
#pragma unroll
    for (int ai = 0; ai < 2; ++ai)
#pragma unroll
        for (int m = 0; m < 4; ++m) r[ai][m] = rstd_of(rs, u.pm * 256 + ai * 128 + wr * 64 + m * 16 + fr);
#pragma unroll
    for (int ai = 0; ai < 2; ++ai)
#pragma unroll
        for (int m = 0; m < 4; ++m)
#pragma unroll
            for (int bj = 0; bj < 2; ++bj) {
                const int row = u.pm * 256 + ai * 128 + wr * 64 + m * 16 + fr; const int col0 = u.pn * 256 + bj * 128 + wc * 32 + 8 * fq;
                e.row8(u.z, row, col0, acc[ai][bj][m][0] * r[ai][m], acc[ai][bj][m][1] * r[ai][m]);
            }
}
template <class E> DI void epi_rows(const E& e, const Acc& acc, const Unit& u, int wr, int wc, int fr, int fq) {
#pragma unroll
    for (int ai = 0; ai < 2; ++ai)
#pragma unroll
        for (int m = 0; m < 4; ++m)
#pragma unroll
            for (int bj = 0; bj < 2; ++bj) {
                const int row = u.pm * 256 + ai * 128 + wr * 64 + m * 16 + fr; const int col0 = u.pn * 256 + bj * 128 + wc * 32 + 8 * fq;
                e.row8(u.z, row, col0, acc[ai][bj][m][0], acc[ai][bj][m][1]);
            }
}
struct EpiStore {
    bf16_t* O; int ldc; long sOz; const float* rs; const float* cs;
    DI void row8(int z, int row, int col0, f32x4 v0, f32x4 v1) const {
        if (cs) { const f32x4 s0 = *(const f32x4*)(cs + col0), s1 = *(const f32x4*)(cs + col0 + 4);
#pragma unroll
            for (int i = 0; i < 4; ++i) { v0[i] *= rsqrtf(s0[i] * (1.f / D) + EPS); v1[i] *= rsqrtf(s1[i] * (1.f / D) + EPS); } }
        *(u32x4*)(O + (size_t)z * sOz + (size_t)row * ldc + col0) = pack8(v0, v1); }
    DI void naive(const Unit& u, int row, int wc, int fq, const f32x4 a0, const f32x4 a1, const f32x4 b0, const f32x4 b1) const { row8(u.z, row, u.pn * 256 + wc * 32 + 8 * fq, a0, a1); row8(u.z, row, u.pn * 256 + 128 + wc * 32 + 8 * fq, b0, b1); }
    DI void operator()(const Acc& acc, const Unit& u, int wr, int wc, int fr, int fq) const { if (rs) epi_rows_scaled(*this, rs, acc, u, wr, wc, fr, fq); else epi_rows(*this, acc, u, wr, wc, fr, fq); }
};
struct EpiInProj {
    bf16_t* Ug; bf16_t* Big; float* Logits; const float* rs;
    DI void row8(int z, int row, int col0, const f32x4 v0, const f32x4 v1) const {
        if (col0 < 512) { const int g = col0 >> 4, c = col0 & 15, b = row >> 11, s = row & 2047, n = s >> 5, j = s & 31;
            *(u32x4*)(Ug + ((size_t)(g * S5ROWS + b * S5NCH + n)) * S5K + j * 16 + c) = pack8(v0, v1); }
        else if (col0 < 2560) { *(u32x4*)(Big + (size_t)row * ABPAD + col0) = pack8(v0, v1); }
        else if (col0 == 2560) { *(f32x4*)(Logits + (size_t)row * 8) = v0; *(f32x4*)(Logits + (size_t)row * 8 + 4) = v1; }
    }
    DI void naive(const Unit& u, int row, int wc, int fq, const f32x4 a0, const f32x4 a1, const f32x4 b0, const f32x4 b1) const { row8(u.z, row, u.pn * 256 + wc * 32 + 8 * fq, a0, a1); row8(u.z, row, u.pn * 256 + 128 + wc * 32 + 8 * fq, b0, b1); }
    DI void operator()(const Acc& acc, const Unit& u, int wr, int wc, int fr, int fq) const { epi_rows_scaled(*this, rs, acc, u, wr, wc, fr, fq); }
};
struct EpiResid {
    bf16_t* XB; float* OutF; float* PSn; LAS float* part;
    DI void operator()(const Acc& acc, const Unit& u, int wr, int wc, int fr, int fq) const {
#pragma unroll
        for (int ai = 0; ai < 2; ++ai)
#pragma unroll
            for (int m = 0; m < 4; ++m) {
                const int row = u.pm * 256 + ai * 128 + wr * 64 + m * 16 + fr; float s = 0.f;
#pragma unroll
                for (int bj = 0; bj < 2; ++bj) { const int col0 = u.pn * 256 + bj * 128 + wc * 32 + 8 * fq;
                    bf16_t* p = XB + (size_t)row * D + col0; float xv[8]; unpack8(*(const u32x4*)p, xv);
                    const f32x4 a = (f32x4){xv[0], xv[1], xv[2], xv[3]} + acc[ai][bj][m][0], b = (f32x4){xv[4], xv[5], xv[6], xv[7]} + acc[ai][bj][m][1];
                    if (OutF) { float* o = OutF + (size_t)row * D + col0; *(f32x4*)o = a; *(f32x4*)(o + 4) = b; } else *(u32x4*)p = pack8(a, b);
                    s += (a[0] * a[0] + a[1] * a[1]) + (a[2] * a[2] + a[3] * a[3]) + (b[0] * b[0] + b[1] * b[1]) + (b[2] * b[2] + b[3] * b[3]); }
                s += __shfl_xor(s, 16); s += __shfl_xor(s, 32);
                if (fq == 0) part[(ai * 128 + wr * 64 + m * 16 + fr) * 4 + wc] = s;
            }
        asm volatile("s_waitcnt lgkmcnt(0)" ::: "memory"); __builtin_amdgcn_s_barrier(); asm volatile("" ::: "memory");
        if (PSn) { const int t = threadIdx.x; if (t < 256) { const f32x4 p4 = *(const LAS f32x4*)(part + t * 4); PSn[(size_t)(u.pm * 256 + t) * 4 + u.pn] = (p4[0] + p4[1]) + (p4[2] + p4[3]); } }
        asm volatile("s_waitcnt lgkmcnt(0)" ::: "memory"); __builtin_amdgcn_s_barrier(); asm volatile("" ::: "memory");
    }
    DI void naive(const Unit& u, int row, int wc, int fq, const f32x4 a0, const f32x4 a1, const f32x4 b0, const f32x4 b1) const { }
};
struct EpiSwiglu {
    bf16_t* H; const float* rs;
    DI void naive(const Unit& u, int row, int wc, int fq, const f32x4 a0, const f32x4 a1, const f32x4 b0, const f32x4 b1) const {
        const int hid = u.pn * 128 + wc * 32 + 8 * fq; f32x4 h0, h1;
#pragma unroll
        for (int i = 0; i < 4; ++i) { h0[i] = siluf_(a0[i]) * b0[i]; h1[i] = siluf_(a1[i]) * b1[i]; }
        *(u32x4*)(H + (size_t)row * FF + hid) = pack8(h0, h1);
    }
    DI void operator()(const Acc& acc, const Unit& u, int wr, int wc, int fr, int fq) const {
        float rr[2][4];
#pragma unroll
        for (int ai = 0; ai < 2; ++ai)
#pragma unroll
            for (int m = 0; m < 4; ++m) rr[ai][m] = rstd_of(rs, u.pm * 256 + ai * 128 + wr * 64 + m * 16 + fr);
#pragma unroll
        for (int ai = 0; ai < 2; ++ai)
#pragma unroll
            for (int m = 0; m < 4; ++m) {
                const int row = u.pm * 256 + ai * 128 + wr * 64 + m * 16 + fr; const int hid = u.pn * 128 + wc * 32 + 8 * fq; const float r = rr[ai][m];
                f32x4 h0, h1;
#pragma unroll
                for (int i = 0; i < 4; ++i) { h0[i] = siluf_(acc[ai][0][m][0][i] * r) * acc[ai][1][m][0][i] * r; h1[i] = siluf_(acc[ai][0][m][1][i] * r) * acc[ai][1][m][1][i] * r; }
                *(u32x4*)(H + (size_t)row * FF + hid) = pack8(h0, h1);
            }
    }
};
struct EpiS5State {
    float* S;
    DI void row8(int z, int row, int col0, const f32x4 v0, const f32x4 v1) const { if (col0 < 128) { float* p = S + ((size_t)z * S5ROWS + row) * 128 + col0; *(f32x4*)p = v0; *(f32x4*)(p + 4) = v1; } }
    DI void naive(const Unit& u, int row, int wc, int fq, const f32x4 a0, const f32x4 a1, const f32x4 b0, const f32x4 b1) const { row8(u.z, row, u.pn * 256 + wc * 32 + 8 * fq, a0, a1); row8(u.z, row, u.pn * 256 + 128 + wc * 32 + 8 * fq, b0, b1); }
    DI void operator()(const Acc& acc, const Unit& u, int wr, int wc, int fr, int fq) const { epi_rows(*this, acc, u, wr, wc, fr, fq); }
};
struct EpiS5Y {
    const bf16_t* Ug; const float* dvec; bf16_t* Big;
    DI void row8(int z, int row, int col0, const f32x4 v0, const f32x4 v1) const {
        const int t = col0 >> 4, c = col0 & 15; const int token = (row >> 6) * SEQ + (row & 63) * S5L + t;
        const u32x4 uw = *(const u32x4*)(Ug + ((size_t)z * S5ROWS + row) * S5K + t * 16 + c); float uu[8]; unpack8(uw, uu);
        const f32x4 d0 = *(const f32x4*)(dvec + z * 16 + c); const f32x4 d1 = *(const f32x4*)(dvec + z * 16 + c + 4);
        f32x4 y0, y1;
#pragma unroll
        for (int i = 0; i < 4; ++i) { const float k_ = (DBG_SKIP & 32) ? 0.f : 1.f; y0[i] = gelu_tanh(k_ * v0[i] + d0[i] * uu[i]); y1[i] = gelu_tanh(k_ * v1[i] + d1[i] * uu[4 + i]); }
        *(u32x4*)(Big + (size_t)token * ABPAD + z * 16 + c) = pack8(y0, y1);
    }
    DI void naive(const Unit& u, int row, int wc, int fq, const f32x4 a0, const f32x4 a1, const f32x4 b0, const f32x4 b1) const { row8(u.z, row, u.pn * 256 + wc * 32 + 8 * fq, a0, a1); row8(u.z, row, u.pn * 256 + 128 + wc * 32 + 8 * fq, b0, b1); }
    DI void operator()(const Acc& acc, const Unit& u, int wr, int wc, int fr, int fq) const { epi_rows(*this, acc, u, wr, wc, fr, fq); }
};
struct EpiGlu {
    const bf16_t* Big; const float* bias; bf16_t* Mix;
    DI void row8(int z, int row, int col0, const f32x4 v0, const f32x4 v1) const {
        const u32x4 hw = *(const u32x4*)(Big + (size_t)row * ABPAD + col0); float hh[8]; unpack8(hw, hh);
        const f32x4 b0 = *(const f32x4*)(bias + col0); const f32x4 b1 = *(const f32x4*)(bias + col0 + 4);
        f32x4 o0, o1;
#pragma unroll
        for (int i = 0; i < 4; ++i) { o0[i] = hh[i] * sigmoidf_(v0[i] + b0[i]); o1[i] = hh[4 + i] * sigmoidf_(v1[i] + b1[i]); }
        if (DBG_SKIP & 4) { o0 = (f32x4){0.f,0.f,0.f,0.f}; o1 = o0; }
        if (DBG_HALF & 4) { o0 = o0 * DBG_A; o1 = o1 * DBG_A; }
        *(u32x4*)(Mix + (size_t)row * D + col0) = pack8(o0, o1);
    }
    DI void naive(const Unit& u, int row, int wc, int fq, const f32x4 a0, const f32x4 a1, const f32x4 b0, const f32x4 b1) const { row8(u.z, row, u.pn * 256 + wc * 32 + 8 * fq, a0, a1); row8(u.z, row, u.pn * 256 + 128 + wc * 32 + 8 * fq, b0, b1); }
    DI void operator()(const Acc& acc, const Unit& u, int wr, int wc, int fr, int fq) const { epi_rows(*this, acc, u, wr, wc, fr, fq); }
};
}

struct Ctx { LAS unsigned char* lds; int tid, lane, wave, gw, ngw; };
DI Ctx make_ctx(LAS unsigned char* lds) {
    Ctx C; int t = threadIdx.x; asm volatile("" : "+v"(t));
    C.lds = lds; C.tid = t; C.lane = t & 63; C.wave = __builtin_amdgcn_readfirstlane(t >> 6);
    C.gw = blockIdx.x * NWAVES + C.wave; C.ngw = gridDim.x * NWAVES; return C;
}

DI void tr_item(const float* W, int K, int N, int ldw, int n_off, bf16_t* WT, int row_off, int grp, int gstride, LAS float* scr, int item, int lane, const float* gain = nullptr) {
    const int nblk = (N + 31) / 32, kb = item / nblk, nb = item % nblk, k0 = 64 * kb, n0 = 32 * nb;
    const int rr = lane >> 3, cc = (lane & 7) * 4; const bool ok = (n0 + cc) < N;
    f32x4 v[8];
#pragma unroll
    for (int i = 0; i < 8; ++i) { const f32x4 t4 = *(const f32x4*)(W + (size_t)(k0 + 8 * i + rr) * ldw + n_off + n0 + (ok ? cc : 0)); v[i] = ok ? t4 : (f32x4){0.f, 0.f, 0.f, 0.f}; }
#pragma unroll
    for (int i = 0; i < 8; ++i) { const int kk = 8 * i + rr; const float gk = gain ? gain[k0 + kk] : 1.f; LAS float* sp = scr + kk * 33 + cc; sp[0] = v[i][0] * gk; sp[1] = v[i][1] * gk; sp[2] = v[i][2] * gk; sp[3] = v[i][3] * gk; }
    asm volatile("s_waitcnt lgkmcnt(0)" ::: "memory");
    const int c = lane & 7;
#pragma unroll
    for (int j = 0; j < 4; ++j) { const int n = (lane >> 3) + 8 * j; const LAS float* s = scr + (8 * c) * 33 + n;
        u32x4 o; o.x = cvt_pk_bf16(s[0 * 33], s[1 * 33]); o.y = cvt_pk_bf16(s[2 * 33], s[3 * 33]); o.z = cvt_pk_bf16(s[4 * 33], s[5 * 33]); o.w = cvt_pk_bf16(s[6 * 33], s[7 * 33]);
        const int q = n0 + n; const int drow = row_off + (q / grp) * gstride + (q % grp);
        *(u32x4*)(WT + (size_t)drow * K + k0 + 8 * c) = o; }
    asm volatile("s_waitcnt lgkmcnt(0)" ::: "memory");
}
DI void conv_mat(const Ctx& C, const float* W, int K, int N, int ldw, int n_off, bf16_t* WT, int row_off, int grp, int gstride) {
#if DBG_NAIVE
    { const size_t tot = (size_t)K * N; const size_t stride = (size_t)C.ngw * 64;
      for (size_t idx = (size_t)C.gw * 64 + C.lane; idx < tot; idx += stride) { const int n = (int)(idx / K), k = (int)(idx % K);
          const int drow = row_off + (n / grp) * gstride + (n % grp); WT[(size_t)drow * K + k] = f2bf(W[(size_t)k * ldw + n_off + n]); }
      return; }
#endif
    LAS float* scr = (LAS float*)(C.lds + C.wave * 16384);
    const int items = (K / 64) * ((N + 31) / 32);
    for (int it = C.gw; it < items; it += C.ngw) tr_item(W, K, N, ldw, n_off, WT, row_off, grp, gstride, scr, it, C.lane);
}
DI void rms_rows(const Ctx& C, const float* X, const float* gain, bf16_t* O, int rows) {
#if DBG_NAIVE
    { const int gt = C.gw * 64 + C.lane, nth = C.ngw * 64;
      for (int r = gt; r < rows; r += nth) { const float* xr = X + (size_t)r * D; float s = 0.f; for (int k = 0; k < D; ++k) s += xr[k] * xr[k];
          const float rstd = 1.0f / sqrtf(s / (float)D + EPS); for (int k = 0; k < D; ++k) O[(size_t)r * D + k] = f2bf(xr[k] * rstd * gain[k]); }
      return; }
#endif
    const f32x4 g0 = *(const f32x4*)(gain + 4 * C.lane), g1 = *(const f32x4*)(gain + 256 + 4 * C.lane), g2 = *(const f32x4*)(gain + 512 + 4 * C.lane), g3 = *(const f32x4*)(gain + 768 + 4 * C.lane);
    for (int r = C.gw; r < rows; r += C.ngw) {
        const f32x4* xr = (const f32x4*)(X + (size_t)r * D) + C.lane;
        f32x4 v0 = xr[0], v1 = xr[64], v2 = xr[128], v3 = xr[192];
        float s = (v0[0]*v0[0] + v0[1]*v0[1]) + (v0[2]*v0[2] + v0[3]*v0[3]) + (v1[0]*v1[0] + v1[1]*v1[1]) + (v1[2]*v1[2] + v1[3]*v1[3])
                + (v2[0]*v2[0] + v2[1]*v2[1]) + (v2[2]*v2[2] + v2[3]*v2[3]) + (v3[0]*v3[0] + v3[1]*v3[1]) + (v3[2]*v3[2] + v3[3]*v3[3]);
        const float rstd = rsqrtf(wave_sum(s) * (1.f / D) + EPS);
        v0 = v0 * rstd * g0; v1 = v1 * rstd * g1; v2 = v2 * rstd * g2; v3 = v3 * rstd * g3;
        u32x2* o = (u32x2*)(O + (size_t)r * D) + C.lane;
        o[0]   = (u32x2){cvt_pk_bf16(v0[0], v0[1]), cvt_pk_bf16(v0[2], v0[3])};
        o[64]  = (u32x2){cvt_pk_bf16(v1[0], v1[1]), cvt_pk_bf16(v1[2], v1[3])};
        o[128] = (u32x2){cvt_pk_bf16(v2[0], v2[1]), cvt_pk_bf16(v2[2], v2[3])};
        o[192] = (u32x2){cvt_pk_bf16(v3[0], v3[1]), cvt_pk_bf16(v3[2], v3[3])};
    }
}
DI void rms_rows_b(const Ctx& C, const bf16_t* Xb, const float* gain, bf16_t* O, int rows) {
    f32x4 g[4];
#pragma unroll
    for (int j = 0; j < 4; ++j) g[j] = *(const f32x4*)(gain + 256 * j + 4 * C.lane);
    for (int r = C.gw; r < rows; r += C.ngw) {
        const u32x2* xr = (const u32x2*)(Xb + (size_t)r * D) + C.lane; f32x4 v[4]; float s = 0.f;
#pragma unroll
        for (int j = 0; j < 4; ++j) { const u32x2 w = xr[64 * j]; v[j] = (f32x4){bflo(w.x), bfhi(w.x), bflo(w.y), bfhi(w.y)}; s += (v[j][0] * v[j][0] + v[j][1] * v[j][1]) + (v[j][2] * v[j][2] + v[j][3] * v[j][3]); }
        const float rstd = rsqrtf(wave_sum(s) * (1.f / D) + EPS);
        u32x2* o = (u32x2*)(O + (size_t)r * D) + C.lane;
#pragma unroll
        for (int j = 0; j < 4; ++j) { const f32x4 y = v[j] * rstd * g[j]; o[64 * j] = (u32x2){cvt_pk_bf16(y[0], y[1]), cvt_pk_bf16(y[2], y[3])}; }
    }
}
DI void x_prep(const Ctx& C, const float* Xin, bf16_t* XB, float* PS0) {
    for (int r = C.gw; r < M; r += C.ngw) {
        const f32x4* xr = (const f32x4*)(Xin + (size_t)r * D) + C.lane; u32x2* xb = (u32x2*)(XB + (size_t)r * D) + C.lane; float s = 0.f;
#pragma unroll
        for (int j = 0; j < 4; ++j) { const f32x4 v = xr[64 * j]; xb[64 * j] = (u32x2){cvt_pk_bf16(v[0], v[1]), cvt_pk_bf16(v[2], v[3])}; s += (v[0] * v[0] + v[1] * v[1]) + (v[2] * v[2] + v[3] * v[3]); }
        s = wave_sum(s); if (C.lane < 4) PS0[(size_t)r * 4 + C.lane] = C.lane == 0 ? s : 0.f;
    }
}
DI void copy_f32(const Ctx& C, const float* src, float* dst, size_t n4) {
    const size_t stride = (size_t)C.ngw * 64;
    for (size_t i = (size_t)C.gw * 64 + C.lane; i < n4; i += stride) ((f32x4*)dst)[i] = ((const f32x4*)src)[i];
}
DI void knorm_phase(const Ctx& C, bf16_t* KALL, const float* kg  ) {
    for (int r = C.gw; r < MMEM * 16; r += C.ngw) {
        const int tok = r >> 4, lh = r & 15, layer = lh >> 2;
        u32x2* p = (u32x2*)(KALL + (size_t)tok * 4096 + lh * 256) + C.lane;
        const u32x2 w = *p; float v0 = bflo(w.x), v1 = bfhi(w.x), v2 = bflo(w.y), v3 = bfhi(w.y);
        const float rstd = rsqrtf(wave_sum(v0 * v0 + v1 * v1 + v2 * v2 + v3 * v3) * (1.f / 256.f) + EPS);
        const f32x4 g = *(const f32x4*)(kg + layer * 256 + 4 * C.lane);
        *p = (u32x2){cvt_pk_bf16(v0 * rstd * g[0], v1 * rstd * g[1]), cvt_pk_bf16(v2 * rstd * g[2], v3 * rstd * g[3])};
    }
}

DI void s5_build(const Ctx& C, const float* a_re, const float* a_im, const float* log_dt, const float* b_re, const float* b_im, const float* c_re, const float* c_im, bf16_t* T, bf16_t* Bm) {
    LAS float* lamr = (LAS float*)C.lds; LAS float* lami = lamr + 64; LAS float* Bre = lami + 64; LAS float* Bim = Bre + 1024; LAS float* Cre = Bim + 1024; LAS float* Cim = Cre + 1024;
    LAS unsigned short* Kd = (LAS unsigned short*)(Cim + 1024);
    for (int u = blockIdx.x; u < 32 * 8; u += gridDim.x) {
        const int g = u >> 3, part = u & 7, tlo = part * 4;
        __syncthreads();
        const float dt = __expf(log_dt[g]);
        if (C.tid < 64) { const int p = C.tid; const float ar = a_re[g * 64 + p], ai = a_im[g * 64 + p]; float sn, cs; sincosf(ai * dt, &sn, &cs); const float mag = __expf(ar * dt); lamr[p] = mag * cs; lami[p] = mag * sn; }
        for (int e = C.tid; e < 1024; e += NTHR) { Cre[e] = c_re[(size_t)g * 1024 + e]; Cim[e] = c_im[(size_t)g * 1024 + e]; }
        __syncthreads();
        for (int e = C.tid; e < 1024; e += NTHR) { const int p = e >> 4; const float ar = a_re[g * 64 + p], ai = a_im[g * 64 + p];
            const float nr = lamr[p] - 1.f, ni = lami[p]; const float inv = 1.f / (ar * ar + ai * ai);
            const float qr = (nr * ar + ni * ai) * inv, qi = (ni * ar - nr * ai) * inv;
            const float br = b_re[(size_t)g * 1024 + e], bi = b_im[(size_t)g * 1024 + e];
            Bre[e] = qr * br - qi * bi; Bim[e] = qr * bi + qi * br; }
        __syncthreads();
        for (int pass = 0; pass < 2; ++pass) { const int entry = pass * 128 + (C.tid >> 2), qt = C.tid & 3, c = entry >> 4, cp = entry & 15;
          float wr_[16], wi_[16];
#pragma unroll
          for (int k = 0; k < 16; ++k) { const int p = 16 * qt + k; wr_[k] = Bre[p * 16 + cp]; wi_[k] = Bim[p * 16 + cp]; }
          for (int dl = 0; dl <= tlo + 3; ++dl) {
              float s = 0.f;
#pragma unroll
              for (int k = 0; k < 16; ++k) { const int p = 16 * qt + k; s += Cre[c * 64 + p] * wr_[k] - Cim[c * 64 + p] * wi_[k];
                  const float nr = wr_[k] * lamr[p] - wi_[k] * lami[p], ni = wr_[k] * lami[p] + wi_[k] * lamr[p]; wr_[k] = nr; wi_[k] = ni; }
              s += __shfl_xor(s, 1); s += __shfl_xor(s, 2);
              if (qt == 0) Kd[dl * 256 + entry] = f2bf(s);
          } }
        __syncthreads();
        for (int idx = C.tid; idx < 4 * 16 * 64; idx += NTHR) { const int hf = idx & 1, j = (idx >> 1) & 31, c = (idx >> 6) & 15, t = tlo + (idx >> 10);
            u32x4 w = (u32x4){0u, 0u, 0u, 0u}; if (j <= t) w = *(const LAS u32x4*)(Kd + (t - j) * 256 + c * 16 + hf * 8);
            *(u32x4*)(T + ((size_t)g * 512 + t * 16 + c) * S5K + j * 16 + hf * 8) = w; }
        for (int e = C.tid; e < 1024; e += NTHR) {
            { const int c = e >> 6, p = e & 63; float er = lamr[p], ei = lami[p];
              for (int k = 0; k < tlo; ++k) { const float nr = er * lamr[p] - ei * lami[p], ni = er * lami[p] + ei * lamr[p]; er = nr; ei = ni; }
              const float cr = Cre[e], ci = Cim[e];
              for (int t = tlo; t < tlo + 4; ++t) { *(unsigned*)(T + ((size_t)g * 512 + t * 16 + c) * S5K + 512 + 2 * p) = cvt_pk_bf16(cr * er - ci * ei, -(cr * ei + ci * er));
                  const float nr = er * lamr[p] - ei * lami[p], ni = er * lami[p] + ei * lamr[p]; er = nr; ei = ni; } }
            { const int p = e >> 4, cp = e & 15; float er = 1.f, ei = 0.f;
              for (int k = 0; k < 31 - (tlo + 3); ++k) { const float nr = er * lamr[p] - ei * lami[p], ni = er * lami[p] + ei * lamr[p]; er = nr; ei = ni; }
              const float br = Bre[e], bi = Bim[e];
              for (int j = tlo + 3; j >= tlo; --j) { Bm[((size_t)g * 256 + 2 * p) * 512 + j * 16 + cp] = f2bf(er * br - ei * bi); Bm[((size_t)g * 256 + 2 * p + 1) * 512 + j * 16 + cp] = f2bf(er * bi + ei * br);
                  const float nr = er * lamr[p] - ei * lami[p], ni = er * lami[p] + ei * lamr[p]; er = nr; ei = ni; } }
        }
    }
    __syncthreads();
}
DI void s5_scan(const Ctx& C, const float* a_re, const float* a_im, const float* log_dt, const float* S, bf16_t* Ug) {
    const int gt = blockIdx.x * NTHR + C.tid;
    if (gt < BATCH * 32 * 64) {
        const int p = gt & 63, g = (gt >> 6) & 31, b = gt >> 11;
        const float dt = __expf(log_dt[g]); const float ar = a_re[g * 64 + p], ai = a_im[g * 64 + p];
        float sn, cs; sincosf(ai * dt * 32.f, &sn, &cs); const float mag = __expf(ar * dt * 32.f); const float lr = mag * cs, li = mag * sn;
        float xr = 0.f, xi = 0.f;
        const size_t row0 = (size_t)g * S5ROWS + b * S5NCH;
        for (int nb = 0; nb < S5NCH; nb += 32) {
            f32x2 sv[32];
#pragma unroll
            for (int j = 0; j < 32; ++j) sv[j] = *(const f32x2*)(S + (row0 + nb + j) * 128 + 2 * p);
#pragma unroll
            for (int j = 0; j < 32; ++j) {
                *(unsigned*)(Ug + (row0 + nb + j) * S5K + 512 + 2 * p) = cvt_pk_bf16(xr, xi);
                const float nr = lr * xr - li * xi + sv[j][0], ni = lr * xi + li * xr + sv[j][1]; xr = nr; xi = ni;
            }
        }
    }
}

DI void gdn_pre(const Ctx& C, const bf16_t* Big, const float* Logits, const float* conv_w  , const float* a_log, const float* dt_bias, unsigned char* scr, unsigned char* hn) {
    constexpr int LD = 129;
    constexpr int LB = 136;
    LAS float* kf = (LAS float*)C.lds; LAS float* vf = kf + 64 * LD; LAS float* qf = vf + 64 * LD; LAS float* Lm = qf;
    LAS bf16_t* qb = (LAS bf16_t*)(qf + 64 * LD); LAS bf16_t* kb = qb + 64 * LB; LAS float* gc = (LAS float*)(kb + 64 * LB); LAS float* be = gc + 64;
    bf16_t* WK = (bf16_t*)(hn + HN_WK); bf16_t* UT = (bf16_t*)(scr + SC_UT); bf16_t* QG = (bf16_t*)(scr + SC_QG); bf16_t* KT = (bf16_t*)(hn + HN_KT); bf16_t* QK = (bf16_t*)(scr + SC_QK); float* DEC = (float*)(scr + SC_DEC);
    for (int u = blockIdx.x; u < BATCH * 4 * 32; u += gridDim.x) {
        const int b = u >> 7, h = (u >> 5) & 3, n = u & 31; const int tok0 = b * SEQ + n * 64;
        __syncthreads();
        { const int d = C.tid & 127, tq = C.tid >> 7, t0 = tq * 16; const int s0 = n * 64 + t0;
          float xin[3][19];
#pragma unroll
          for (int part = 0; part < 3; ++part) { const bf16_t* src = Big + 512 + part * 512 + h * 128 + d;
#pragma unroll
              for (int i = 0; i < 19; ++i) { const int si = s0 - 3 + i, sc_ = si < 0 ? 0 : si; const float xv = bf2f(src[(size_t)(b * SEQ + sc_) * ABPAD]); xin[part][i] = si < 0 ? 0.f : xv; } }
#pragma unroll
          for (int part = 0; part < 3; ++part) {
              const int ch = part * 512 + h * 128 + d; const float w0 = conv_w[ch], w1 = conv_w[1536 + ch], w2 = conv_w[2 * 1536 + ch], w3 = conv_w[3 * 1536 + ch];
              LAS float* dst = part == 0 ? qf : (part == 1 ? kf : vf);
#pragma unroll
              for (int i = 0; i < 16; ++i) { const float y = w0 * xin[part][i] + w1 * xin[part][i + 1] + w2 * xin[part][i + 2] + w3 * xin[part][i + 3]; dst[(t0 + i) * LD + d] = siluf_(y); }
          } }
        if (C.wave == 0) { const int t = C.lane; const float a = Logits[(size_t)(tok0 + t) * 8 + h], bl = Logits[(size_t)(tok0 + t) * 8 + 4 + h];
            const float x = a + dt_bias[h]; const float sp = x > 20.f ? x : log1pf(__expf(x)); float gv = -__expf(a_log[h]) * sp;
#pragma unroll
            for (int o = 1; o < 64; o <<= 1) { const float y = __shfl_up(gv, o); if (t >= o) gv += y; }
            gc[t] = gv; be[t] = sigmoidf_(bl); }
        __syncthreads();
        for (int r = C.wave; r < 128; r += NWAVES) { LAS float* rowp = (r < 64 ? qf + r * LD : kf + (r - 64) * LD); const float v0 = rowp[C.lane], v1 = rowp[C.lane + 64];
            const float sc = rsqrtf(wave_sum(v0 * v0 + v1 * v1) + EPS) * (r < 64 ? 0.08838834764831845f : 1.f); rowp[C.lane] = v0 * sc; rowp[C.lane + 64] = v1 * sc;
            LAS bf16_t* bp = (r < 64 ? qb + r * LB : kb + (r - 64) * LB); bp[C.lane] = f2bf(v0 * sc); bp[C.lane + 64] = f2bf(v1 * sc); }
        __syncthreads();
        { const int w = C.wave, mt = w >> 1, l15 = C.lane & 15, lq = C.lane >> 4;
          f32x4 akk[2], aqk[2];
#pragma unroll
          for (int q2 = 0; q2 < 2; ++q2) { akk[q2] = (f32x4){0.f, 0.f, 0.f, 0.f}; aqk[q2] = akk[q2]; }
#pragma unroll
          for (int ks = 0; ks < 4; ++ks) { const bf16x8 af = *(const LAS bf16x8*)(kb + (16 * mt + l15) * LB + 32 * ks + 8 * lq);
#pragma unroll
              for (int q2 = 0; q2 < 2; ++q2) { const int nt = (w & 1) * 2 + q2;
                  const bf16x8 bk = *(const LAS bf16x8*)(kb + (16 * nt + l15) * LB + 32 * ks + 8 * lq), bq = *(const LAS bf16x8*)(qb + (16 * nt + l15) * LB + 32 * ks + 8 * lq);
                  akk[q2] = __builtin_amdgcn_mfma_f32_16x16x32_bf16(af, bk, akk[q2], 0, 0, 0); aqk[q2] = __builtin_amdgcn_mfma_f32_16x16x32_bf16(af, bq, aqk[q2], 0, 0, 0); } }
          __syncthreads();
#pragma unroll
          for (int q2 = 0; q2 < 2; ++q2) { const int nt = (w & 1) * 2 + q2;
              { const int j = 16 * nt + l15; const float gj = gc[j]; f32x4 lv;
#pragma unroll
                for (int i = 0; i < 4; ++i) { const int t = 16 * mt + 4 * lq + i; lv[i] = (t > j) ? be[t] * akk[q2][i] * __expf(gc[t] - gj) : 0.f; }
                *(LAS f32x4*)(Lm + j * 64 + 16 * mt + 4 * lq) = lv; }
              { const int t = 16 * nt + l15; const float gt_ = gc[t]; f32x4 qv;
#pragma unroll
                for (int i = 0; i < 4; ++i) { const int j = 16 * mt + 4 * lq + i; qv[i] = (t >= j) ? aqk[q2][i] * __expf(gt_ - gc[j]) : 0.f; }
                *(u32x2*)(QK + (size_t)u * 4096 + t * 64 + 16 * mt + 4 * lq) = (u32x2){cvt_pk_bf16(qv[0], qv[1]), cvt_pk_bf16(qv[2], qv[3])}; } } }
        __syncthreads();
        { const float glast = gc[63];
          for (int e = C.tid; e < 64 * 16; e += NTHR) { const int t = e >> 4, d0 = (e & 15) * 8; const float gm = __expf(gc[t]); f32x4 a, b2;
#pragma unroll
              for (int i = 0; i < 4; ++i) { a[i] = bf2f(qb[t * LB + d0 + i]) * gm; b2[i] = bf2f(qb[t * LB + d0 + 4 + i]) * gm; }
              *(u32x4*)(QG + (size_t)u * 8192 + t * 128 + d0) = pack8(a, b2); }
          for (int e = C.tid; e < 128 * 8; e += NTHR) { const int d = e >> 3, t0 = (e & 7) * 8; f32x4 a, b2;
#pragma unroll
              for (int i = 0; i < 4; ++i) { a[i] = kf[(t0 + i) * LD + d] * __expf(glast - gc[t0 + i]); b2[i] = kf[(t0 + 4 + i) * LD + d] * __expf(glast - gc[t0 + 4 + i]); }
              *(u32x4*)(KT + (size_t)u * 8192 + d * 64 + t0) = pack8(a, b2); }
          if (C.tid == 0) DEC[u] = __expf(glast); }
        __syncthreads();
        if (C.tid < 256) {
            const int col = C.tid; LAS float* base = (col < 128) ? (vf + col) : (kf + (col - 128));
            for (int tb = 0; tb < 4; ++tb) {
                float acc[16];
#pragma unroll
                for (int i = 0; i < 16; ++i) { const int t = tb * 16 + i; const float sc = (col < 128) ? be[t] : be[t] * __expf(gc[t]); acc[i] = base[t * LD] * sc; }
                for (int j = 0; j < tb * 16; ++j) { const float s = base[j * LD]; const LAS f32x4* lp = (const LAS f32x4*)(Lm + j * 64 + tb * 16);
                    const f32x4 l0 = lp[0], l1 = lp[1], l2 = lp[2], l3 = lp[3];
#pragma unroll
                    for (int i = 0; i < 4; ++i) { acc[i] -= l0[i] * s; acc[4 + i] -= l1[i] * s; acc[8 + i] -= l2[i] * s; acc[12 + i] -= l3[i] * s; } }
#pragma unroll
                for (int j = 0; j < 15; ++j) { const float s = acc[j]; const LAS float* lp = Lm + (tb * 16 + j) * 64 + tb * 16;
#pragma unroll
                    for (int i = j + 1; i < 16; ++i) acc[i] -= lp[i] * s; }
#pragma unroll
                for (int i = 0; i < 16; ++i) base[(tb * 16 + i) * LD] = acc[i];
            }
        }
        __syncthreads();
        for (int e = C.tid; e < 128 * 8; e += NTHR) { const int ee = e >> 3, t0 = (e & 7) * 8;
            *(u32x4*)(UT + (size_t)u * 8192 + ee * 64 + t0) = pack8((f32x4){vf[t0 * LD + ee], vf[(t0 + 1) * LD + ee], vf[(t0 + 2) * LD + ee], vf[(t0 + 3) * LD + ee]}, (f32x4){vf[(t0 + 4) * LD + ee], vf[(t0 + 5) * LD + ee], vf[(t0 + 6) * LD + ee], vf[(t0 + 7) * LD + ee]}); }
        for (int e = C.tid; e < 64 * 16; e += NTHR) { const int t = e >> 4, d0 = (e & 15) * 8; f32x4 a, b2;
#pragma unroll
            for (int i = 0; i < 4; ++i) { a[i] = kf[t * LD + d0 + i]; b2[i] = kf[t * LD + d0 + 4 + i]; }
            *(u32x4*)(WK + (size_t)u * 8192 + t * 128 + d0) = pack8(a, b2); }
    }
    __syncthreads();
}
DI void gdn_seq(const Ctx& C, const unsigned char* scr, const unsigned char* hn, float* GO  ) {
    const bf16_t* WK = (const bf16_t*)(hn + HN_WK); const bf16_t* UT = (const bf16_t*)(scr + SC_UT); const bf16_t* QG = (const bf16_t*)(scr + SC_QG); const bf16_t* KT = (const bf16_t*)(hn + HN_KT); const bf16_t* QK = (const bf16_t*)(scr + SC_QK); const float* DEC = (const float*)(scr + SC_DEC);
    constexpr int STLD = 136, WTLD = 72;
    LAS bf16_t* ST = (LAS bf16_t*)C.lds; LAS bf16_t* WT = ST + 16 * STLD; LAS float* decs = (LAS float*)(WT + 16 * WTLD);
    const int w = C.wave, l15 = C.lane & 15, lq = C.lane >> 4;
    for (int blk = blockIdx.x; blk < BATCH * 4 * 8; blk += gridDim.x) {
        const int bh = blk >> 3, es = blk & 7, b = bh >> 2, h = bh & 3;
        f32x4 Sreg = (f32x4){0.f, 0.f, 0.f, 0.f};
        __syncthreads();
        *(LAS u32x2*)(ST + l15 * STLD + 16 * w + 4 * lq) = (u32x2){0u, 0u};
        if (C.tid < 32) { int idx = bh * 32 + C.tid; asm volatile("" : "+v"(idx)); decs[C.tid] = DEC[idx]; }
        __syncthreads();
        const int mt = w & 3;
        bf16x8 a1[4], a2[2], a3[2]; u32x2 uw = (u32x2){0u, 0u}; float dec = 0.f; a2[0] = (bf16x8){0, 0, 0, 0, 0, 0, 0, 0}; a2[1] = a2[0];
#define GS_LOAD(n_) do { const size_t u_ = (size_t)bh * 32 + (n_); \
            const bf16_t* As_ = (w < 4 ? WK : QG) + u_ * 8192 + (16 * mt + l15) * 128 + 8 * lq; \
            _Pragma("unroll") for (int ks = 0; ks < 4; ++ks) a1[ks] = *(const bf16x8*)(As_ + 32 * ks); \
            if (w >= 4) { _Pragma("unroll") for (int ks = 0; ks < 2; ++ks) a2[ks] = *(const bf16x8*)(QK + u_ * 4096 + (16 * mt + l15) * 64 + 32 * ks + 8 * lq); } \
            else uw = *(const u32x2*)(UT + u_ * 8192 + (es * 16 + l15) * 64 + 16 * mt + 4 * lq); \
            _Pragma("unroll") for (int ks = 0; ks < 2; ++ks) a3[ks] = *(const bf16x8*)(KT + u_ * 8192 + (16 * w + l15) * 64 + 32 * ks + 8 * lq); \
            dec = decs[(n_)]; } while (0)
        GS_LOAD(0);
        for (int n = 0; n < 32; ++n) {
            bf16x8 c1[4], c2[2], c3[2];
#pragma unroll
            for (int ks = 0; ks < 4; ++ks) c1[ks] = a1[ks];
#pragma unroll
            for (int ks = 0; ks < 2; ++ks) { c2[ks] = a2[ks]; c3[ks] = a3[ks]; }
            u32x2 cuw = uw; float cdec = dec;
#pragma unroll
            for (int ks = 0; ks < 4; ++ks) asm volatile("" : "+v"(c1[ks]));
#pragma unroll
            for (int ks = 0; ks < 2; ++ks) asm volatile("" : "+v"(c2[ks]), "+v"(c3[ks]));
            asm volatile("" : "+v"(cuw), "+v"(cdec));
            if (n + 1 < 32) GS_LOAD(n + 1);
            f32x4 acc = (f32x4){0.f, 0.f, 0.f, 0.f};
#pragma unroll
            for (int ks = 0; ks < 4; ++ks) { const bf16x8 bb = *(const LAS bf16x8*)(ST + l15 * STLD + 32 * ks + 8 * lq); acc = __builtin_amdgcn_mfma_f32_16x16x32_bf16(c1[ks], bb, acc, 0, 0, 0); }
            if (w < 4) { const f32x4 uu = (f32x4){bflo(cuw.x), bfhi(cuw.x), bflo(cuw.y), bfhi(cuw.y)}; const f32x4 wv = uu - acc;
                *(LAS u32x2*)(WT + l15 * WTLD + 16 * mt + 4 * lq) = (u32x2){cvt_pk_bf16(wv[0], wv[1]), cvt_pk_bf16(wv[2], wv[3])}; }
            asm volatile("s_waitcnt lgkmcnt(0)" ::: "memory"); __builtin_amdgcn_s_barrier(); asm volatile("" ::: "memory");
            bf16x8 wb[2];
#pragma unroll
            for (int ks = 0; ks < 2; ++ks) wb[ks] = *(const LAS bf16x8*)(WT + l15 * WTLD + 32 * ks + 8 * lq);
            if (w >= 4) {
#pragma unroll
                for (int ks = 0; ks < 2; ++ks) acc = __builtin_amdgcn_mfma_f32_16x16x32_bf16(c2[ks], wb[ks], acc, 0, 0, 0);
                float* o = GO + (size_t)(b * SEQ + n * 64 + 16 * mt + 4 * lq) * 512 + h * 128 + es * 16 + l15;
#pragma unroll
                for (int i = 0; i < 4; ++i) o[(size_t)i * 512] = acc[i];
            }
            { f32x4 sn = Sreg * cdec;
#pragma unroll
              for (int ks = 0; ks < 2; ++ks) sn = __builtin_amdgcn_mfma_f32_16x16x32_bf16(c3[ks], wb[ks], sn, 0, 0, 0);
              Sreg = sn; }
            *(LAS u32x2*)(ST + l15 * STLD + 16 * w + 4 * lq) = (u32x2){cvt_pk_bf16(Sreg[0], Sreg[1]), cvt_pk_bf16(Sreg[2], Sreg[3])};
            asm volatile("s_waitcnt lgkmcnt(0)" ::: "memory"); __builtin_amdgcn_s_barrier(); asm volatile("" ::: "memory");
        }
#undef GS_LOAD
    }
    __syncthreads();
}
DI void gdn_post(const Ctx& C, const float* GO, const bf16_t* Big, const float* out_g, bf16_t* Mix) {
    const f32x2 g = *(const f32x2*)(out_g + 2 * C.lane);
    for (int tok = C.gw; tok < M; tok += C.ngw) {
        f32x2 o[4];
#pragma unroll
        for (int h = 0; h < 4; ++h) o[h] = *(const f32x2*)(GO + (size_t)tok * 512 + h * 128 + 2 * C.lane);
        float ss[4];
#pragma unroll
        for (int h = 0; h < 4; ++h) ss[h] = wave_sum(o[h][0] * o[h][0] + o[h][1] * o[h][1]);
        unsigned outw[4];
#pragma unroll
        for (int h = 0; h < 4; ++h) { const float rstd = rsqrtf(ss[h] * (1.f / 128.f) + EPS);
            const unsigned gw_ = *(const unsigned*)(Big + (size_t)tok * ABPAD + 2048 + h * 128 + 2 * C.lane);
            outw[h] = cvt_pk_bf16(o[h][0] * rstd * g[0] * siluf_(bflo(gw_)), o[h][1] * rstd * g[1] * siluf_(bfhi(gw_))); }
        asm volatile("" ::: "memory");
#pragma unroll
        for (int h = 0; h < 4; ++h) *(unsigned*)(Mix + (size_t)tok * D + 512 + h * 128 + 2 * C.lane) = outw[h];
    }
}

#define MFMA32(a, b, c) __builtin_amdgcn_mfma_f32_32x32x16_bf16((a), (b), (c), 0, 0, 0)
DI bf16x8 mk8(unsigned a, unsigned b, unsigned c, unsigned d) { return __builtin_bit_cast(bf16x8, (u32x4){a, b, c, d}); }

DI void chunk_attn(const Ctx& C, const bf16_t* QKb  , const bf16_t* VT  , bf16_t* Mix, const float* qg, const float* kg, const float* relb  ) {
    constexpr int KLD = 72, VLD = 72;
    LAS bf16_t* Kt = (LAS bf16_t*)C.lds;
    LAS bf16_t* Vt = Kt + 4 * 64 * KLD;
    LAS float* bias = (LAS float*)(Vt + 4 * 64 * VLD);
    const int w = C.wave, r = C.lane & 31, hh = C.lane >> 5, hw = w >> 1, qb = w & 1;
    for (int u = blockIdx.x; u < BATCH * 32 * 4; u += gridDim.x) {
        const int b = u >> 7, c = (u >> 2) & 31, hg = u & 3; const int head = hg * 4 + hw;
        __syncthreads();
        for (int i = C.tid; i < 4 * 257; i += NTHR) { const int h4 = i / 257, k = i - h4 * 257; bias[h4 * 260 + k] = relb[(hg * 4 + h4) * 257 + k] * 1.4426950408889634f; }
        const int qrow = b * SEQ + c * 64 + qb * 32 + r;
        bf16x8 qfr[4];
        { float qv[4][8]; float ss = 0.f;
#pragma unroll
          for (int s = 0; s < 4; ++s) { const u32x4 wq = *(const u32x4*)(QKb + (size_t)qrow * 2048 + head * 64 + 16 * s + 8 * hh); unpack8(wq, qv[s]);
#pragma unroll
              for (int j = 0; j < 8; ++j) ss += qv[s][j] * qv[s][j]; }
          ss += __shfl_xor(ss, 32); const float rstd = rsqrtf(ss * (1.f / 64.f) + EPS) * (0.125f * 1.4426950408889634f);
#pragma unroll
          for (int s = 0; s < 4; ++s) { const f32x4 g0 = *(const f32x4*)(qg + 16 * s + 8 * hh), g1 = *(const f32x4*)(qg + 16 * s + 8 * hh + 4);
              qfr[s] = mk8(cvt_pk_bf16(qv[s][0] * rstd * g0[0], qv[s][1] * rstd * g0[1]), cvt_pk_bf16(qv[s][2] * rstd * g0[2], qv[s][3] * rstd * g0[3]),
                           cvt_pk_bf16(qv[s][4] * rstd * g1[0], qv[s][5] * rstd * g1[1]), cvt_pk_bf16(qv[s][6] * rstd * g1[2], qv[s][7] * rstd * g1[3])); } }
        float mrun = -1e30f, lrun = 0.f; f32x16 O0, O1;
#pragma unroll
        for (int i = 0; i < 16; ++i) { O0[i] = 0.f; O1[i] = 0.f; }
        const int c0 = c > 8 ? c - 8 : 0; const int qpos = c * 64 + qb * 32 + r;
        u32x4 pk[4], pv[4];
#define CA_LOAD(kc_) do { _Pragma("unroll") for (int i = 0; i < 4; ++i) { const int pid = C.tid + NTHR * i; const int h4 = pid >> 9, row_ = (pid >> 3) & 63, pc = pid & 7; \
            pk[i] = *(const u32x4*)(QKb + (size_t)(b * SEQ + (kc_) * 64 + row_) * 2048 + 1024 + (hg * 4 + h4) * 64 + pc * 8); \
            pv[i] = *(const u32x4*)(VT + (size_t)((hg * 4 + h4) * 64 + row_) * M + b * SEQ + (kc_) * 64 + pc * 8); } } while (0)
        CA_LOAD(c0);
        for (int kc = c0; kc <= c; ++kc) {
            __syncthreads();
#pragma unroll
            for (int i = 0; i < 4; ++i) { const int pid = C.tid + NTHR * i; const int h4 = pid >> 9, row_ = (pid >> 3) & 63, pc = pid & 7;
                float kv[8]; unpack8(pk[i], kv);
                float ss = 0.f;
#pragma unroll
                for (int j = 0; j < 8; ++j) ss += kv[j] * kv[j];
                ss += __shfl_xor(ss, 1); ss += __shfl_xor(ss, 2); ss += __shfl_xor(ss, 4);
                const float rstd = rsqrtf(ss * (1.f / 64.f) + EPS); const f32x4 g0 = *(const f32x4*)(kg + pc * 8), g1 = *(const f32x4*)(kg + pc * 8 + 4);
                *(LAS u32x4*)(Kt + (h4 * 64 + row_) * KLD + pc * 8) = (u32x4){cvt_pk_bf16(kv[0] * rstd * g0[0], kv[1] * rstd * g0[1]), cvt_pk_bf16(kv[2] * rstd * g0[2], kv[3] * rstd * g0[3]),
                                                                              cvt_pk_bf16(kv[4] * rstd * g1[0], kv[5] * rstd * g1[1]), cvt_pk_bf16(kv[6] * rstd * g1[2], kv[7] * rstd * g1[3])};
                *(LAS u32x4*)(Vt + (h4 * 64 + row_) * VLD + pc * 8) = pv[i]; }
            __syncthreads();
            if (kc < c) CA_LOAD(kc + 1);
#pragma unroll
            for (int sub = 0; sub < 2; ++sub) {
                f32x16 acc;
#pragma unroll
                for (int i = 0; i < 16; ++i) acc[i] = 0.f;
#pragma unroll
                for (int s = 0; s < 4; ++s) { const bf16x8 a = *(const LAS bf16x8*)(Kt + (hw * 64 + sub * 32 + r) * KLD + 16 * s + 8 * hh); acc = MFMA32(a, qfr[s], acc); }
                float mt = -1e30f; const int kbase = kc * 64 + sub * 32;
                if (qpos - (kbase + 31) >= 128) {
                    const float bc = bias[hw * 260 + 256];
#pragma unroll
                    for (int i = 0; i < 16; ++i) { acc[i] += bc; mt = fmaxf(mt, acc[i]); }
                } else {
#pragma unroll
                    for (int i = 0; i < 16; ++i) { const int krow = (i & 3) + 8 * (i >> 2) + 4 * hh; int rel = qpos - (kbase + krow); rel = rel > 128 ? 128 : (rel < -128 ? -128 : rel);
                        acc[i] += bias[hw * 260 + rel + 128]; mt = fmaxf(mt, acc[i]); }
                }
                mt = fmaxf(mt, __shfl_xor(mt, 32));
                const float mnew = fmaxf(mrun, mt), alpha = __builtin_amdgcn_exp2f(mrun - mnew); float ls = 0.f;
#pragma unroll
                for (int i = 0; i < 16; ++i) { acc[i] = __builtin_amdgcn_exp2f(acc[i] - mnew); ls += acc[i]; }
                ls += __shfl_xor(ls, 32); lrun = lrun * alpha + ls; mrun = mnew;
                if (__builtin_amdgcn_ballot_w64(alpha != 1.f) != 0ull) {
#pragma unroll
                    for (int i = 0; i < 16; ++i) { O0[i] *= alpha; O1[i] *= alpha; } }
                const bf16x8 pa0 = mk8(cvt_pk_bf16(acc[0], acc[1]), cvt_pk_bf16(acc[2], acc[3]), cvt_pk_bf16(acc[4], acc[5]), cvt_pk_bf16(acc[6], acc[7]));
                const bf16x8 pa1 = mk8(cvt_pk_bf16(acc[8], acc[9]), cvt_pk_bf16(acc[10], acc[11]), cvt_pk_bf16(acc[12], acc[13]), cvt_pk_bf16(acc[14], acc[15]));
#pragma unroll
                for (int db = 0; db < 2; ++db) {
                    const LAS bf16_t* vrow = Vt + (hw * 64 + db * 32 + r) * VLD + sub * 32;
                    const u32x2 l0 = *(const LAS u32x2*)(vrow + 4 * hh), h0 = *(const LAS u32x2*)(vrow + 8 + 4 * hh), l1 = *(const LAS u32x2*)(vrow + 16 + 4 * hh), h1 = *(const LAS u32x2*)(vrow + 24 + 4 * hh);
                    if (db == 0) { O0 = MFMA32(mk8(l0.x, l0.y, h0.x, h0.y), pa0, O0); O0 = MFMA32(mk8(l1.x, l1.y, h1.x, h1.y), pa1, O0); }
                    else         { O1 = MFMA32(mk8(l0.x, l0.y, h0.x, h0.y), pa0, O1); O1 = MFMA32(mk8(l1.x, l1.y, h1.x, h1.y), pa1, O1); }
                }
            }
        }
#undef CA_LOAD
        const float inv = 1.f / lrun;
        bf16_t* orow = Mix + (size_t)qrow * D + head * 64;
#pragma unroll
        for (int q4 = 0; q4 < 4; ++q4) {
            *(u32x2*)(orow + 8 * q4 + 4 * hh)      = (u32x2){cvt_pk_bf16(O0[4 * q4] * inv, O0[4 * q4 + 1] * inv), cvt_pk_bf16(O0[4 * q4 + 2] * inv, O0[4 * q4 + 3] * inv)};
            *(u32x2*)(orow + 32 + 8 * q4 + 4 * hh) = (u32x2){cvt_pk_bf16(O1[4 * q4] * inv, O1[4 * q4 + 1] * inv), cvt_pk_bf16(O1[4 * q4 + 2] * inv, O1[4 * q4 + 3] * inv)};
        }
    }
    __syncthreads();
}

DI void cross_attn(const Ctx& C, const bf16_t* QX  , const bf16_t* KALL  , const bf16_t* VTALL  , bf16_t* Mix, const float* qg  , int layer) {
    constexpr int KLD = 264, VLD = 40;
    LAS bf16_t* Kt = (LAS bf16_t*)C.lds;
    LAS bf16_t* Vt = Kt + 32 * KLD;
    LAS bf16x8* Qs = (LAS bf16x8*)(Vt + 256 * VLD);
    const int w = C.wave, r = C.lane & 31, hh = C.lane >> 5, qs = w >> 1, dh = w & 1;
    for (int u = blockIdx.x; u < BATCH * 4 * 16; u += gridDim.x) {
        const int b = u >> 6, head = (u >> 4) & 3, qg16 = u & 15;
        const int qrow = b * SEQ + qg16 * 128 + qs * 32 + r;
        __syncthreads();
        { float ss = 0.f; const bf16_t* qp = QX + (size_t)qrow * D + head * 256 + 8 * hh;
#pragma unroll
          for (int s = 0; s < 16; ++s) { const u32x4 w4 = *(const u32x4*)(qp + 16 * s); float qv[8]; unpack8(w4, qv);
#pragma unroll
              for (int j = 0; j < 8; ++j) ss += qv[j] * qv[j]; }
          ss += __shfl_xor(ss, 32); const float rstd = rsqrtf(ss * (1.f / 256.f) + EPS) * (0.0625f * 1.4426950408889634f);
#pragma unroll
          for (int s = 0; s < 16; ++s) { const u32x4 w4 = *(const u32x4*)(qp + 16 * s); float qv[8]; unpack8(w4, qv); const f32x4 g0 = *(const f32x4*)(qg + 16 * s + 8 * hh), g1 = *(const f32x4*)(qg + 16 * s + 8 * hh + 4);
              const bf16x8 fr = mk8(cvt_pk_bf16(qv[0] * rstd * g0[0], qv[1] * rstd * g0[1]), cvt_pk_bf16(qv[2] * rstd * g0[2], qv[3] * rstd * g0[3]),
                           cvt_pk_bf16(qv[4] * rstd * g1[0], qv[5] * rstd * g1[1]), cvt_pk_bf16(qv[6] * rstd * g1[2], qv[7] * rstd * g1[3]));
              if (dh == 0) Qs[(qs * 16 + s) * 64 + C.lane] = fr; } }
        float mrun = -1e30f, lrun = 0.f; f32x16 O[4];
#pragma unroll
        for (int db = 0; db < 4; ++db)
#pragma unroll
            for (int i = 0; i < 16; ++i) O[db][i] = 0.f;
        u32x4 pk[2], pv[2];
#define XA_LOAD(kt_) do { _Pragma("unroll") for (int i = 0; i < 2; ++i) { const int pid = C.tid + NTHR * i; \
            { const int key = pid >> 5, pc = pid & 31; pk[i] = *(const u32x4*)(KALL + (size_t)(b * NMEM + (kt_) * 32 + key) * 4096 + layer * 1024 + head * 256 + pc * 8); } \
            { const int d = pid >> 2, pc = pid & 3; pv[i] = *(const u32x4*)(VTALL + (size_t)(layer * 1024 + head * 256 + d) * MMEM + b * NMEM + (kt_) * 32 + pc * 8); } } } while (0)
        XA_LOAD(0);
        for (int kt = 0; kt < 8; ++kt) {
            __syncthreads();
#pragma unroll
            for (int i = 0; i < 2; ++i) { const int pid = C.tid + NTHR * i; { const int key = pid >> 5, pc = pid & 31; *(LAS u32x4*)(Kt + key * KLD + pc * 8) = pk[i]; }
                { const int d = pid >> 2, pc = pid & 3; *(LAS u32x4*)(Vt + d * VLD + pc * 8) = pv[i]; } }
            __syncthreads();
            if (kt < 7) XA_LOAD(kt + 1);
            f32x16 acc;
#pragma unroll
            for (int i = 0; i < 16; ++i) acc[i] = 0.f;
#pragma unroll
            for (int s = 0; s < 16; ++s) { const bf16x8 a = *(const LAS bf16x8*)(Kt + r * KLD + 16 * s + 8 * hh); acc = MFMA32(a, Qs[(qs * 16 + s) * 64 + C.lane], acc); }
            float mt = -1e30f;
#pragma unroll
            for (int i = 0; i < 16; ++i) mt = fmaxf(mt, acc[i]);
            mt = fmaxf(mt, __shfl_xor(mt, 32));
            const float mnew = fmaxf(mrun, mt), alpha = __builtin_amdgcn_exp2f(mrun - mnew); float ls = 0.f;
#pragma unroll
            for (int i = 0; i < 16; ++i) { acc[i] = __builtin_amdgcn_exp2f(acc[i] - mnew); ls += acc[i]; }
            const bool resc = __builtin_amdgcn_ballot_w64(alpha != 1.f) != 0ull;
            ls += __shfl_xor(ls, 32); lrun = lrun * alpha + ls; mrun = mnew;
            const bf16x8 pa0 = mk8(cvt_pk_bf16(acc[0], acc[1]), cvt_pk_bf16(acc[2], acc[3]), cvt_pk_bf16(acc[4], acc[5]), cvt_pk_bf16(acc[6], acc[7]));
            const bf16x8 pa1 = mk8(cvt_pk_bf16(acc[8], acc[9]), cvt_pk_bf16(acc[10], acc[11]), cvt_pk_bf16(acc[12], acc[13]), cvt_pk_bf16(acc[14], acc[15]));
#pragma unroll
            for (int db = 0; db < 4; ++db) {
                if (resc) {
#pragma unroll
                    for (int i = 0; i < 16; ++i) O[db][i] *= alpha; }
                const LAS bf16_t* vrow = Vt + (dh * 128 + db * 32 + r) * VLD;
                const u32x2 l0 = *(const LAS u32x2*)(vrow + 4 * hh), h0 = *(const LAS u32x2*)(vrow + 8 + 4 * hh), l1 = *(const LAS u32x2*)(vrow + 16 + 4 * hh), h1 = *(const LAS u32x2*)(vrow + 24 + 4 * hh);
                O[db] = MFMA32(mk8(l0.x, l0.y, h0.x, h0.y), pa0, O[db]); O[db] = MFMA32(mk8(l1.x, l1.y, h1.x, h1.y), pa1, O[db]);
            }
        }
        const float inv = 1.f / lrun;
        bf16_t* orow = Mix + (size_t)qrow * D + head * 256 + dh * 128;
#pragma unroll
        for (int db = 0; db < 4; ++db)
#pragma unroll
            for (int q4 = 0; q4 < 4; ++q4)
                *(u32x2*)(orow + db * 32 + 8 * q4 + 4 * hh) = (u32x2){cvt_pk_bf16(O[db][4 * q4] * inv, O[db][4 * q4 + 1] * inv), cvt_pk_bf16(O[db][4 * q4 + 2] * inv, O[db][4 * q4 + 3] * inv)};
    }
    __syncthreads();
}

#define XB_TMO      128
#define XB_XCNT(j)  (256  + 64 * (j))
#define XB_XSUB(j)  (1280 + 64 * (j))
#define XB_XGEN(j)  (2304 + 64 * (j))
#define XB_TOP      3328
#define XB_TOPGEN   3392
#define XB_SPIN_CAP (1u << 22)
DI unsigned xb_ld(unsigned* p)              { return __hip_atomic_load(p, __ATOMIC_RELAXED, __HIP_MEMORY_SCOPE_AGENT); }
DI unsigned xb_add(unsigned* p, unsigned v) { return __hip_atomic_fetch_add(p, v, __ATOMIC_RELAXED, __HIP_MEMORY_SCOPE_AGENT); }
DI unsigned xb_xcc_id() { return (unsigned)__builtin_amdgcn_s_getreg((3 << 11) | 20) & 0xFu; }
#define XB_SPIN(cond, bar) do { unsigned _sp = 0; while (cond) { __builtin_amdgcn_s_sleep(1); \
    if ((++_sp & 255u) == 0u) { if (xb_ld(&(bar)[XB_TMO])) break; if (_sp > XB_SPIN_CAP) { atomicAdd(&(bar)[XB_TMO], 1u); break; } } } } while (0)
struct XcdBarrier { unsigned* bar; unsigned x; volatile LAS unsigned* st; };
DI XcdBarrier xcd_barrier_post(unsigned* bar, volatile LAS unsigned* st) {
    XcdBarrier b; b.bar = bar; b.x = xb_xcc_id(); b.st = st;
    if (threadIdx.x == 0) (void)xb_add(&bar[XB_XCNT(b.x)], 1u);
    return b;
}
DI void xcd_barrier_complete(unsigned* bar, unsigned x, unsigned& nloc, unsigned& nx) {
    const unsigned G = gridDim.x * gridDim.y * gridDim.z;
    unsigned sum, cnt, mine, sp = 0u;
    for (;;) {
        sum = 0u; cnt = 0u; mine = 0u;
#pragma unroll
        for (unsigned j = 0; j < 16; ++j) { const unsigned c = xb_ld(&bar[XB_XCNT(j)]); sum += c; cnt += (c > 0u) ? 1u : 0u; mine = (j == x) ? c : mine; }
        if (sum == G) break;
        __builtin_amdgcn_s_sleep(1);
        if ((++sp & 255u) == 0u) { if (xb_ld(&bar[XB_TMO])) break; if (sp > XB_SPIN_CAP) { atomicAdd(&bar[XB_TMO], 1u); break; } }
    }
    nloc = mine > 0u ? mine : 1u; nx = cnt > 0u ? cnt : 1u;
}
DI void xcd_barrier(const XcdBarrier& b) {
    asm volatile("s_waitcnt vmcnt(0)" ::: "memory");
    __syncthreads();
    if (threadIdx.x == 0) {
        unsigned* bar = b.bar;
        __builtin_amdgcn_s_waitcnt(0);
        unsigned nloc = b.st[0], nx = b.st[1];
        if (nloc == 0u) { xcd_barrier_complete(bar, b.x, nloc, nx); b.st[0] = nloc; b.st[1] = nx; }
        const unsigned old = xb_add(&bar[XB_XSUB(b.x)], 1u);
        const unsigned gen = old / nloc;
        if (old + 1u == (gen + 1u) * nloc) {
            __builtin_amdgcn_fence(__ATOMIC_RELEASE, "agent");
            asm volatile("s_waitcnt vmcnt(0)" ::: "memory");
            const unsigned og = xb_add(&bar[XB_TOP], 1u);
            const unsigned tg = og / nx;
            if (og + 1u == (tg + 1u) * nx) xb_add(&bar[XB_TOPGEN], 1u);
            else XB_SPIN(xb_ld(&bar[XB_TOPGEN]) == tg, bar);
            __builtin_amdgcn_fence(__ATOMIC_ACQUIRE, "agent");
            xb_add(&bar[XB_XGEN(b.x)], 1u);
            asm volatile("s_waitcnt vmcnt(0)" ::: "memory");
        } else {
            XB_SPIN(xb_ld(&bar[XB_XGEN(b.x)]) == gen, bar);
            __builtin_amdgcn_fence(__ATOMIC_ACQUIRE, "agent");
            asm volatile("s_waitcnt vmcnt(0)" ::: "memory");
        }
    }
    __syncthreads();
}
struct Args { const float* in[36]; float* out; unsigned char* wsp; int ph_lo, ph_hi; };
constexpr int NPHASES = 43;

#define CV_JOB(W_, K_, N_, ldw_, noff_, WT_, rowoff_, grp_, gstride_, gain_) { const int items_ = ((K_) / 64) * (((N_) + 31) / 32); \
        if (r < items_) { tr_item((W_), (K_), (N_), (ldw_), (noff_), (WT_), (rowoff_), (grp_), (gstride_), scr_, r, C.lane, (gain_)); continue; } r -= items_; }
DI void convert_layer(const Ctx& C, const Args& a, int layer) {
    unsigned char* wl_ = a.wsp + WS_WL; const int i = layer >> 1;
    LAS float* scr_ = (LAS float*)(C.lds + C.wave * 16384);
    constexpr int NO = 1 << 20;
    if ((layer & 1) == 0) {
        constexpr int TOT = 16 * 81 + 16 * 32 + 8 * 16 + 2 * 16 * 32 + 2 * 16 * 88 + 44 * 32;
        for (int it = C.gw; it < TOT; it += C.ngw) { int r = it;
            CV_JOB(a.in[3] + (size_t)i * D * ABIN, D, ABIN, ABIN, 0, (bf16_t*)(wl_ + WL_IN), 0, NO, 0, a.in[2] + i * D)
            CV_JOB(a.in[4] + (size_t)i * D * D, D, D, D, 0, (bf16_t*)(wl_ + WL_OUT), 0, NO, 0, nullptr)
            CV_JOB(a.in[13] + (size_t)i * 512 * 512, 512, 512, 512, 0, (bf16_t*)(wl_ + WL_GLU), 0, NO, 0, nullptr)
            CV_JOB(a.in[27] + (size_t)layer * D * D, D, D, D, 0, (bf16_t*)(wl_ + WL_XQ), 0, NO, 0, a.in[26] + layer * D)
            CV_JOB(a.in[29] + (size_t)layer * D * D, D, D, D, 0, (bf16_t*)(wl_ + WL_XO), 0, NO, 0, nullptr)
            CV_JOB(a.in[33] + (size_t)layer * D * FF, D, FF, FF, 0, (bf16_t*)(wl_ + WL_GU), 0, 128, 256, a.in[32] + layer * D)
            CV_JOB(a.in[34] + (size_t)layer * D * FF, D, FF, FF, 0, (bf16_t*)(wl_ + WL_GU), 128, 128, 256, a.in[32] + layer * D)
            CV_JOB(a.in[35] + (size_t)layer * FF * D, FF, D, D, 0, (bf16_t*)(wl_ + WL_DN), 0, NO, 0, nullptr)
        }
        s5_build(C, a.in[5] + i * 2048, a.in[6] + i * 2048, a.in[7] + i * 32, a.in[8] + (size_t)i * 32768, a.in[9] + (size_t)i * 32768, a.in[10] + (size_t)i * 32768, a.in[11] + (size_t)i * 32768,
                 (bf16_t*)(a.wsp + WS_SCR + SC_T), (bf16_t*)(a.wsp + WS_SCR + SC_BM));
    } else {
        constexpr int TOT = 16 * 64 + 16 * 32 + 16 * 32 + 2 * 16 * 32 + 2 * 16 * 88 + 44 * 32;
        for (int it = C.gw; it < TOT; it += C.ngw) { int r = it;
            CV_JOB(a.in[20] + (size_t)i * D * 3 * D, D, 2 * D, 3 * D, 0, (bf16_t*)(wl_ + WL_IN), 0, NO, 0, a.in[19] + i * D)
            CV_JOB(a.in[20] + (size_t)i * D * 3 * D, D, D, 3 * D, 2 * D, (bf16_t*)(wl_ + WL_V), 0, NO, 0, a.in[19] + i * D)
            CV_JOB(a.in[21] + (size_t)i * D * D, D, D, D, 0, (bf16_t*)(wl_ + WL_OUT), 0, NO, 0, nullptr)
            CV_JOB(a.in[27] + (size_t)layer * D * D, D, D, D, 0, (bf16_t*)(wl_ + WL_XQ), 0, NO, 0, a.in[26] + layer * D)
            CV_JOB(a.in[29] + (size_t)layer * D * D, D, D, D, 0, (bf16_t*)(wl_ + WL_XO), 0, NO, 0, nullptr)
            CV_JOB(a.in[33] + (size_t)layer * D * FF, D, FF, FF, 0, (bf16_t*)(wl_ + WL_GU), 0, 128, 256, a.in[32] + layer * D)
            CV_JOB(a.in[34] + (size_t)layer * D * FF, D, FF, FF, 0, (bf16_t*)(wl_ + WL_GU), 128, 128, 256, a.in[32] + layer * D)
            CV_JOB(a.in[35] + (size_t)layer * FF * D, FF, D, D, 0, (bf16_t*)(wl_ + WL_DN), 0, NO, 0, nullptr)
        }
    }
}

__global__ void __launch_bounds__(NTHR, 2) fwd_kernel(Args a) {
    extern __shared__ __attribute__((aligned(16))) unsigned char lds_raw[];
    LAS unsigned char* lds = (LAS unsigned char*)lds_raw;
#define ws     ws_
#define wl     (ws_ + WS_WL)
#define scr    (ws_ + WS_SCR)
#define PSJ(j) ((float*)(ws_ + WS_PS + (size_t)((j) & 1) * MiB))
#define SSC    ((float*)(ws_ + WS_SS))
#define OUTF   xo_
#define XB     ((bf16_t*)(ws_ + WS_MIX))
#define MIX    ((bf16_t*)xo_)
#define HN     ((bf16_t*)((unsigned char*)xo_ + 32 * MiB))
#define BIG    ((bf16_t*)(ws_ + WS_BIG))
#define LOGITS ((float*)(ws_ + WS_LOG))
#define KALL   ((bf16_t*)(ws_ + WS_KALL))
#define VTALL  ((bf16_t*)(ws_ + WS_VTALL))
#define MEMN   ((bf16_t*)(ws_ + WS_MEMN))
    volatile LAS unsigned* MISC = (volatile LAS unsigned*)(lds + LDS_BYTES - 64);
    if (threadIdx.x < 16) MISC[threadIdx.x] = 0u;
    __syncthreads();
    XcdBarrier xbar; xbar.bar = (unsigned*)a.wsp; xbar.x = 0; xbar.st = nullptr;
    if (a.ph_hi - a.ph_lo > 1) xbar = xcd_barrier_post((unsigned*)a.wsp, MISC);
    const int lo = a.ph_lo, hi = a.ph_hi; int ph = 0;
#define PH_BEGIN if (ph >= lo && ph < hi) { const Ctx C = make_ctx(lds); unsigned char* ws_ = a.wsp; float* xo_ = a.out; int G = gridDim.x, bx = blockIdx.x; \
        asm volatile("" : "+s"(ws_), "+s"(xo_), "+s"(G), "+s"(bx));
#define PH_END   if (ph + 1 < hi) { if (ph == lo) cg::this_grid().sync(); else { xcd_barrier(xbar); if (DBG_DOUBLE & 512) xcd_barrier(xbar); } } } ++ph;
    using namespace pg8;
    PH_BEGIN
        { LAS float* scr_ = (LAS float*)(C.lds + C.wave * 16384);
          for (int it = C.gw; it < 8 * 512; it += C.ngw) { const int job = it >> 9, l = job & 3, isv = job >> 2;
              tr_item(a.in[28] + (size_t)l * D * 2 * D, D, D, 2 * D, isv * D, (bf16_t*)(scr + SC_WKV + (size_t)isv * 8 * MiB), l * 1024, 1 << 20, 0, scr_, it & 511, C.lane); } }
        convert_layer(C, a, 0);
        if (DBG_DOUBLE & 256) convert_layer(C, a, 0);
        rms_rows(C, a.in[1], a.in[25], MEMN, MMEM);
        x_prep(C, a.in[0], XB, PSJ(0));
    PH_END
    PH_BEGIN
        const int half = G / 2; const bool second = bx >= half;
        if (!second) { Gemm g{MEMN, (const bf16_t*)(scr + SC_WKV), D, D, D, 0, 0}; Order S{MMEM / 256, 4096 / 256, 1, half, bx}; EpiStore E{KALL, 4096, 0, nullptr, nullptr}; gemm_phase<EpiStore, true>(lds, g, S, E); }
        else         { Gemm g{(const bf16_t*)(scr + SC_WKV + 8 * MiB), MEMN, D, D, D, 0, 0}; Order S{4096 / 256, MMEM / 256, 1, G - half, bx - half}; EpiStore E{VTALL, MMEM, 0, nullptr, nullptr}; gemm_phase<EpiStore, true>(lds, g, S, E); }
    PH_END
    for (int layer = 0; layer < 4; ++layer) {
        const int i = layer >> 1, sj = layer * 3;
        if ((layer & 1) == 0) {
            PH_BEGIN
                if (layer == 0) knorm_phase(C, KALL, a.in[31]);
                Gemm g{XB, (const bf16_t*)(wl + WL_IN), D, D, D, 0, 0}; Order S{M / 256, ABPAD / 256, 1, G, bx}; EpiInProj E{(bf16_t*)(scr + SC_UG), BIG, LOGITS, PSJ(sj)}; gemm_phase<EpiInProj, true>(lds, g, S, E);
            PH_END
            PH_BEGIN
                if (bx < 64) { Gemm g{(const bf16_t*)(scr + SC_UG), (const bf16_t*)(scr + SC_BM), S5K, 512, 512, (long)S5ROWS * S5K, 256L * 512}; Order S{2, 1, 32, 64, bx}; EpiS5State E{(float*)(scr + SC_S)}; gemm_phase<EpiS5State, true>(lds, g, S, E); }
                gdn_pre(C, BIG, LOGITS, a.in[15] + (size_t)i * 4 * 1536, a.in[16] + i * 4, a.in[17] + i * 4, scr, (unsigned char*)HN);
                if (DBG_DOUBLE & 4) gdn_pre(C, BIG, LOGITS, a.in[15] + (size_t)i * 4 * 1536, a.in[16] + i * 4, a.in[17] + i * 4, scr, (unsigned char*)HN);
            PH_END
            PH_BEGIN
                s5_scan(C, a.in[5] + i * 2048, a.in[6] + i * 2048, a.in[7] + i * 32, (const float*)(scr + SC_S), (bf16_t*)(scr + SC_UG));
                gdn_seq(C, scr, (const unsigned char*)HN, (float*)MIX);
            PH_END
            PH_BEGIN
                const int half = G / 2;
                if (bx < half) { Gemm g{(const bf16_t*)(scr + SC_UG), (const bf16_t*)(scr + SC_T), S5K, S5K, S5K, (long)S5ROWS * S5K, 512L * S5K}; Order S{2, 2, 32, half, bx}; EpiS5Y E{(const bf16_t*)(scr + SC_UG), a.in[12] + i * 512, BIG}; gemm_phase<EpiS5Y, true>(lds, g, S, E); }
                else { Ctx C2 = C; C2.gw = (bx - half) * NWAVES + C.wave; C2.ngw = (G - half) * NWAVES; gdn_post(C2, (const float*)MIX, BIG, a.in[18] + i * 128, MIX); }
            PH_END
            PH_BEGIN
                Gemm g{BIG, (const bf16_t*)(wl + WL_GLU), ABPAD, 512, 512, 0, 0}; Order S{M / 256, 2, 1, G, bx}; EpiGlu E{BIG, a.in[14] + i * 512, MIX}; gemm_phase<EpiGlu, true>(lds, g, S, E);
            PH_END
            PH_BEGIN
                Gemm g{MIX, (const bf16_t*)(wl + WL_OUT), D, D, D, 0, 0}; Order S{M / 256, 4, 1, G, bx}; EpiResid E{XB, nullptr, PSJ(sj + 1), (LAS float*)(lds + 131072)}; gemm_phase<EpiResid, true>(lds, g, S, E);
            PH_END
        } else {
            PH_BEGIN
                { Gemm g{XB, (const bf16_t*)(wl + WL_IN), D, D, D, 0, 0}; Order S{M / 256, 8, 1, G, bx}; EpiStore E{BIG, 2048, 0, PSJ(sj), nullptr}; gemm_phase<EpiStore, true>(lds, g, S, E); }
                { Gemm g{(const bf16_t*)(wl + WL_V), XB, D, D, D, 0, 0}; Order S{4, M / 256, 1, G, bx}; EpiStore E{BIG + (size_t)M * 2048, M, 0, nullptr, SSC}; gemm_phase<EpiStore, true>(lds, g, S, E); }
            PH_END
            PH_BEGIN
                chunk_attn(C, BIG, BIG + (size_t)M * 2048, MIX, a.in[22] + i * 64, a.in[23] + i * 64, a.in[24] + (size_t)i * 16 * 257);
                if (DBG_DOUBLE & 2) { chunk_attn(C, BIG, BIG + (size_t)M * 2048, MIX, a.in[22] + i * 64, a.in[23] + i * 64, a.in[24] + (size_t)i * 16 * 257); }
            PH_END
            PH_BEGIN
                { Gemm g{MIX, (const bf16_t*)(wl + WL_OUT), D, D, D, 0, 0}; Order S{M / 256, 4, 1, G, bx}; EpiResid E{XB, nullptr, PSJ(sj + 1), (LAS float*)(lds + 131072)}; gemm_phase<EpiResid, true>(lds, g, S, E); }
            PH_END
        }
        PH_BEGIN
            Gemm g{XB, (const bf16_t*)(wl + WL_XQ), D, D, D, 0, 0}; Order S{M / 256, 4, 1, G, bx}; EpiStore E{BIG, D, 0, PSJ(sj + 1), nullptr}; gemm_phase<EpiStore, true>(lds, g, S, E);
        PH_END
        PH_BEGIN
            cross_attn(C, BIG, KALL, VTALL, MIX, a.in[30] + layer * 256, layer);
                if (DBG_DOUBLE & 1) { cross_attn(C, BIG, KALL, VTALL, MIX, a.in[30] + layer * 256, layer); }
        PH_END
        PH_BEGIN
            { Gemm g{MIX, (const bf16_t*)(wl + WL_XO), D, D, D, 0, 0}; Order S{M / 256, 4, 1, G, bx}; EpiResid E{XB, nullptr, PSJ(sj + 2), (LAS float*)(lds + 131072)}; gemm_phase<EpiResid, true>(lds, g, S, E); }
        PH_END
        PH_BEGIN
            Gemm g{XB, (const bf16_t*)(wl + WL_GU), D, D, D, 0, 0}; Order S{M / 256, 2 * FF / 256, 1, G, bx}; EpiSwiglu E{BIG, PSJ(sj + 2)}; gemm_phase<EpiSwiglu, true>(lds, g, S, E);
        PH_END
        PH_BEGIN
            { Gemm g{BIG, (const bf16_t*)(wl + WL_DN), FF, FF, FF, 0, 0}; Order S{M / 256, 4, 1, G, bx}; EpiResid E{XB, layer == 3 ? OUTF : (float*)nullptr, layer < 3 ? PSJ(sj + 3) : (float*)nullptr, (LAS float*)(lds + 131072)}; gemm_phase<EpiResid, true>(lds, g, S, E); }
        PH_END
        if (layer < 3) {
            PH_BEGIN
                convert_layer(C, a, layer + 1);
                if (DBG_DOUBLE & 256) convert_layer(C, a, layer + 1);
if (((layer + 1) & 1) != 0) { const float* ps = PSJ(sj + 3); float* sc = SSC;
                    for (int r = C.gw * 64 + C.lane; r < M; r += C.ngw * 64) { const f32x4 a4 = *(const f32x4*)(ps + (size_t)r * 4); sc[r] = (a4[0] + a4[1]) + (a4[2] + a4[3]); } }
            PH_END
        }
    }
#if DBG_CHECK
    if (hi == NPHASES) { cg::this_grid().sync(); if (bx == 0 && threadIdx.x == 0) { const unsigned f = *(volatile unsigned*)ws; if (f != 0x7f7f7f7fu) X[0] = 10000.f * (float)f; } }
#endif
}

extern "C" void kernel_launch(void* const* d_in, const int* in_sizes, int n_in, void* d_out, int out_size, void* d_ws, size_t ws_size, hipStream_t stream) {
    static int grid = 0;
    if (grid == 0) {
        if (n_in != 36 || out_size != M * D || ws_size < WS_END) { fprintf(stderr, "kernel_launch: unexpected problem (n_in %d, out %d, ws %zu)\n", n_in, out_size, ws_size); grid = -1; return; }
        int dev = 0, cus = 0;
        hipGetDevice(&dev); hipDeviceGetAttribute(&cus, hipDeviceAttributeMultiprocessorCount, dev);
        if (hipFuncSetAttribute((const void*)fwd_kernel, hipFuncAttributeMaxDynamicSharedMemorySize, LDS_BYTES) != hipSuccess) { fprintf(stderr, "kernel_launch: hipFuncSetAttribute failed\n"); grid = -1; return; }
        int per_cu = 0;
        if (hipOccupancyMaxActiveBlocksPerMultiprocessor(&per_cu, (const void*)fwd_kernel, NTHR, LDS_BYTES) != hipSuccess || per_cu < 1) { fprintf(stderr, "kernel_launch: occupancy query says %d\n", per_cu); per_cu = 1; }
        (void)hipGetLastError();
        grid = cus > 0 ? cus : 256;
    }
    if (grid < 0) return;
#if DBG_CHECK
    (void)hipMemsetAsync(d_ws, 0x7f, 4, stream);
#endif
    (void)hipMemsetAsync(d_ws, 0, 16384, stream);
    Args a{};
    for (int i = 0; i < 36; ++i) a.in[i] = (const float*)d_in[i];
    a.out = (float*)d_out; a.wsp = (unsigned char*)d_ws;
#if MK_ONE_LAUNCH
    a.ph_lo = 0; a.ph_hi = NPHASES;
    void* args[] = {&a};
    hipError_t e = hipLaunchCooperativeKernel((const void*)fwd_kernel, dim3(grid), dim3(NTHR), args, LDS_BYTES, stream);
    if (e != hipSuccess) fprintf(stderr, "cooperative launch failed: %s (grid %d)\n", hipGetErrorString(e), grid);
#else
    for (int p = 0; p < NPHASES; ++p) {
        a.ph_lo = p; a.ph_hi = p + 1;
        hipLaunchKernelGGL(fwd_kernel, dim3(grid), dim3(NTHR), LDS_BYTES, stream, a);
    }
#endif
}
```

```cpp
#include <hip/hip_runtime.h>
#include <hip/hip_cooperative_groups.h>
#include <cstdio>
#include <cstdint>
namespace cg = cooperative_groups;

#define DBG_NAIVE 0
#define DBG_NAIVE_GEMM 0
#define DBG_CHECK 0
#define DBG_SKIP 0
#define DBG_DOUBLE 0
#define DBG_A 1.0f
#define DBG_HALF 0
#ifndef MK_ONE_LAUNCH
#define MK_ONE_LAUNCH 1
#endif

#define LAS __attribute__((address_space(3)))
#define DI __device__ __forceinline__
typedef unsigned short bf16_t;
typedef short bf16x8 __attribute__((ext_vector_type(8)));
typedef float f32x4 __attribute__((ext_vector_type(4)));
typedef float f32x2 __attribute__((ext_vector_type(2)));
typedef float f32x16 __attribute__((ext_vector_type(16)));
typedef unsigned u32x4 __attribute__((ext_vector_type(4)));
typedef unsigned u32x2 __attribute__((ext_vector_type(2)));

constexpr int D = 1024, BATCH = 8, SEQ = 2048, M = BATCH * SEQ, NMEM = 256, MMEM = BATCH * NMEM;
constexpr int ABIN = 2568, ABPAD = 2816, FF = 2816;
constexpr float EPS = 1e-6f;
constexpr int S5L = 32, S5NCH = SEQ / S5L, S5ROWS = BATCH * S5NCH  , S5K = 640;
constexpr int NTHR = 512, NWAVES = 8;
constexpr int LDS_BYTES = 147456;

constexpr size_t MiB = 1u << 20;
constexpr size_t WS_SS = 65536;
constexpr size_t WS_PS = 31 * MiB;
constexpr size_t WS_WL = 1 * MiB;
constexpr size_t WL_IN = 0, WL_OUT = 6 * MiB, WL_GLU = 8 * MiB, WL_XQ = 9 * MiB, WL_XO = 11 * MiB, WL_GU = 13 * MiB, WL_DN = 24 * MiB;
constexpr size_t WL_V = 4 * MiB;
constexpr size_t WS_KALL = 33 * MiB, WS_VTALL = 49 * MiB, WS_MEMN = 65 * MiB, WS_HN = 69 * MiB, WS_MIX = 101 * MiB, WS_BIG = 133 * MiB, WS_LOG = 229 * MiB, WS_SCR = 230 * MiB, WS_END = 330 * MiB;
constexpr size_t SC_UG = 0, SC_T = 20 * MiB, SC_BM = 40 * MiB, SC_S = 48 * MiB;
constexpr size_t SC_WKV = 64 * MiB;
constexpr size_t SC_UT = 56 * MiB, SC_QG = 72 * MiB, SC_QK = 88 * MiB, SC_DEC = 96 * MiB;
constexpr size_t HN_WK = 0, HN_KT = 16 * MiB;

typedef __bf16 bf16x2_t __attribute__((ext_vector_type(2)));
DI unsigned cvt_pk_bf16(float lo, float hi) { const f32x2 v = {lo, hi}; const bf16x2_t b = __builtin_convertvector(v, bf16x2_t); return __builtin_bit_cast(unsigned, b); }
DI float bf2f(unsigned short b) { return __builtin_bit_cast(float, (unsigned)b << 16); }
DI float bflo(unsigned w) { return __builtin_bit_cast(float, w << 16); }
DI float bfhi(unsigned w) { return __builtin_bit_cast(float, w & 0xffff0000u); }
DI unsigned short f2bf(float f) { return (unsigned short)(cvt_pk_bf16(f, 0.f) & 0xffffu); }
DI float wave_sum(float v) {
#pragma unroll
    for (int o = 1; o < 64; o <<= 1) v += __shfl_xor(v, o);
    return v;
}
DI float sigmoidf_(float x) { return 1.f / (1.f + __expf(-x)); }
DI float siluf_(float x) { return x / (1.f + __expf(-x)); }
DI float gelu_tanh(float x) { const float z = 0.7978845608028654f * (x + 0.044715f * x * x * x); return x / (1.f + __expf(-2.f * z)); }
DI u32x4 pack8(const f32x4 a, const f32x4 b) { u32x4 w; w.x = cvt_pk_bf16(a[0], a[1]); w.y = cvt_pk_bf16(a[2], a[3]); w.z = cvt_pk_bf16(b[0], b[1]); w.w = cvt_pk_bf16(b[2], b[3]); return w; }
DI void unpack8(const u32x4 w, float* o) { o[0] = bflo(w.x); o[1] = bfhi(w.x); o[2] = bflo(w.y); o[3] = bfhi(w.y); o[4] = bflo(w.z); o[5] = bfhi(w.z); o[6] = bflo(w.w); o[7] = bfhi(w.w); }

DI float rstd_of(const float* ps, int row) {
    const f32x4 a = *(const f32x4*)(ps + (size_t)row * 4);
    return rsqrtf(((a[0] + a[1]) + (a[2] + a[3])) * (1.f / D) + EPS);
}
namespace pg8 {
constexpr int BM = 256, BK = 64, HALF = 128, HTB = HALF * BK * 2;
DI int lds_byte(int r, int c) { const int st = (r >> 4) * 2 + (c >> 5), rr = r & 15, cc = c & 31, ob = rr * 64 + cc * 2; return st * 1024 + (ob ^ (((ob >> 9) & 1) << 5)); }
DI void stage_rc(int b, int& R, int& C) { const int st = b / 1024, sb = b % 1024, swz = sb ^ (((sb >> 9) & 1) << 5); R = (st >> 1) * 16 + swz / 64; C = (st & 1) * 32 + (swz % 64) / 2; }
DI int perm32(int rho) { const int n = rho >> 4, i = rho & 15; return 8 * (i >> 2) + 4 * n + (i & 3); }

struct Unit { int z, pm, pn; };
struct Gemm { const bf16_t* A; const bf16_t* Bt; int lda, ldb, K; long sAz, sBz; };
struct Order {
    int nM, nN, nZ, G, c;
    DI bool next(int i, Unit& u) const {
        const long L = (long)i * G + c; const int per = nM * nN;
        if (c < 0 || L >= (long)per * nZ) return false;
        u.z = (int)(L / per); int wgid = (int)(L % per);
        if ((per & 63) == 0) {
            const int q = per >> 3, xcd = wgid & 7, off = wgid >> 3; wgid = xcd * q + off;
            const int nig = 8 * nN, gid = wgid / nig, fm = gid * 8, rem = nM - fm, gsz = rem < 8 ? rem : 8, wi = wgid % nig;
            u.pm = fm + wi % gsz; u.pn = wi / gsz;
        } else { u.pm = wgid / nN; u.pn = wgid % nN; }
        return true;
    }
};
typedef f32x4 Acc[2][2][4][2];

template <class Epi>
DI void gemm_phase_naive(const Gemm g, const Order& S, const Epi& E) {
    int tid_ = threadIdx.x; asm volatile("" : "+v"(tid_));
    const int tid = tid_, wid = tid >> 6, lane = tid & 63, wr = wid >> 2, wc = wid & 3, fr = lane & 15, fq = lane >> 4;
    Unit cur;
    for (int ui = 0; S.next(ui, cur); ++ui) {
        const bf16_t* Ab = g.A + (size_t)cur.z * g.sAz; const bf16_t* Bb = g.Bt + (size_t)cur.z * g.sBz;
        for (int am = 0; am < 8; ++am) {
            const int ai = am >> 2, m = am & 3;
            const int row = cur.pm * 256 + ai * 128 + wr * 64 + m * 16 + fr;
            float s[2][8];
            for (int bj = 0; bj < 2; ++bj) {
#pragma unroll
                for (int q = 0; q < 8; ++q) s[bj][q] = 0.f;
                const int col0 = cur.pn * 256 + bj * 128 + wc * 32 + 8 * fq;
                for (int k = 0; k < g.K; k += 8) {
                    float av[8]; unpack8(*(const u32x4*)(Ab + (size_t)row * g.lda + k), av);
#pragma unroll
                    for (int q = 0; q < 8; ++q) { float bv[8]; unpack8(*(const u32x4*)(Bb + (size_t)(col0 + q) * g.ldb + k), bv);
#pragma unroll
                        for (int e = 0; e < 8; ++e) s[bj][q] += av[e] * bv[e]; }
                }
            }
            E.naive(cur, row, wc, fq, (f32x4){s[0][0], s[0][1], s[0][2], s[0][3]}, (f32x4){s[0][4], s[0][5], s[0][6], s[0][7]}, (f32x4){s[1][0], s[1][1], s[1][2], s[1][3]}, (f32x4){s[1][4], s[1][5], s[1][6], s[1][7]});
        }
    }
}
template <class Epi, bool ALIGN_EPI>
DI void gemm_phase(LAS unsigned char* lds, const Gemm g, const Order& S, const Epi& E) {
#if DBG_NAIVE_GEMM
    gemm_phase_naive<Epi>(g, S, E); return;
#endif
    int tid_ = threadIdx.x; asm volatile("" : "+v"(tid_));
    const int tid = tid_, wid = __builtin_amdgcn_readfirstlane(tid >> 6), lane = tid & 63, wr = wid >> 2, wc = wid & 3, fr = lane & 15, fq = lane >> 4;
    const int K = g.K, nt = K / BK;
    unsigned voffA[2], voffB[2];
#pragma unroll
    for (int i = 0; i < 2; ++i) { int R, C; stage_rc(tid * 16 + i * 8192, R, C); const int Rb = (R & ~31) + perm32(R & 31);
        voffA[i] = (unsigned)(R * g.lda + C) * 2u; voffB[i] = (unsigned)(Rb * g.ldb + C) * 2u; }
    const size_t kstep = (size_t)(BK * 2);
    const size_t hA = (size_t)HALF * g.lda * 2, hB = (size_t)HALF * g.ldb * 2;
    const unsigned ldsw = (unsigned)wid * 1024u;
    const int aoff = lds_byte(wr * 64 + fr, fq * 8), boff = lds_byte(wc * 32 + fr, fq * 8);
#define PG8_SA(b, h) (((b) * 2 + (h)) * HTB)
#define PG8_SB(b, h) ((4 + (b) * 2 + (h)) * HTB)
#define PG8_STAGE(bufoff, gbase, voff) do { _Pragma("unroll") for (int _i = 0; _i < 2; ++_i) \
        __builtin_amdgcn_global_load_lds((const unsigned*)((const char*)(gbase) + (voff)[_i]), (LAS unsigned*)(lds + (bufoff) + ldsw + _i * 8192), 16, 0, 0); } while (0)
#define PG8_LDA(dst, b, h) do { _Pragma("unroll") for (int m = 0; m < 4; ++m) _Pragma("unroll") for (int k = 0; k < 2; ++k) dst[m][k] = *(const LAS bf16x8*)(lds + PG8_SA(b, h) + aoff + m * 2048 + k * 1024); } while (0)
#define PG8_LDB(dst, b, h) do { _Pragma("unroll") for (int n = 0; n < 2; ++n) _Pragma("unroll") for (int k = 0; k < 2; ++k) dst[n][k] = *(const LAS bf16x8*)(lds + PG8_SB(b, h) + boff + n * 2048 + k * 1024); } while (0)
#define PG8_MMA(ai, bj, At, Bt) do { __builtin_amdgcn_s_setprio(1); _Pragma("unroll") for (int m = 0; m < 4; ++m) _Pragma("unroll") for (int n = 0; n < 2; ++n) _Pragma("unroll") for (int k = 0; k < 2; ++k) \
        acc[ai][bj][m][n] = __builtin_amdgcn_mfma_f32_16x16x32_bf16(Bt[n][k], At[m][k], acc[ai][bj][m][n], 0, 0, 0); __builtin_amdgcn_s_setprio(0); } while (0)
#define PG8_WAIT_V(n) asm volatile("s_waitcnt vmcnt(" #n ")" ::: "memory")
#define PG8_WAIT_L(n) asm volatile("s_waitcnt lgkmcnt(" #n ")" ::: "memory")
#define PG8_BAR __builtin_amdgcn_s_barrier()
#define PG8_SCHED __builtin_amdgcn_sched_barrier(0)
    Unit cur, nxt; int ui = 0;
    if (!S.next(0, cur)) return;
    Acc acc;
#pragma unroll
    for (int a = 0; a < 2; ++a)
#pragma unroll
        for (int b = 0; b < 2; ++b)
#pragma unroll
            for (int m = 0; m < 4; ++m)
#pragma unroll
                for (int n = 0; n < 2; ++n) acc[a][b][m][n] = (f32x4){0.f, 0.f, 0.f, 0.f};
    bf16x8 At[4][2], B0[2][2], B1[2][2];
    const char* cA = (const char*)g.A + ((size_t)cur.z * g.sAz + (size_t)cur.pm * BM * g.lda) * 2;
    const char* cB = (const char*)g.Bt + ((size_t)cur.z * g.sBz + (size_t)cur.pn * BM * g.ldb) * 2;
    PG8_STAGE(PG8_SB(0, 0), cB, voffB); PG8_STAGE(PG8_SB(0, 1), cB + hB, voffB); PG8_STAGE(PG8_SA(0, 0), cA, voffA); PG8_STAGE(PG8_SA(0, 1), cA + hA, voffA);
    if (wr == 1) PG8_BAR;
    PG8_WAIT_V(2); PG8_BAR;
    PG8_STAGE(PG8_SB(1, 0), cB + kstep, voffB); PG8_STAGE(PG8_SA(1, 0), cA + kstep, voffA); PG8_STAGE(PG8_SB(1, 1), cB + hB + kstep, voffB);
    PG8_WAIT_V(6); PG8_BAR;
    for (;;) {
        const bool has_next = S.next(ui + 1, nxt);
        const char* nA = has_next ? (const char*)g.A + ((size_t)nxt.z * g.sAz + (size_t)nxt.pm * BM * g.lda) * 2 : cA;
        const char* nB = has_next ? (const char*)g.Bt + ((size_t)nxt.z * g.sBz + (size_t)nxt.pn * BM * g.ldb) * 2 : cB;
        for (int t = 0; t < nt; t += 2) {
            const bool last = (t == nt - 2);
            const char* a1 = cA + (size_t)(t + 1) * kstep;
            const char* a2 = last ? nA : cA + (size_t)(t + 2) * kstep; const char* b2 = last ? nB : cB + (size_t)(t + 2) * kstep;
            const char* a3 = a2 + kstep; const char* b3 = b2 + kstep;
            PG8_LDB(B0, 0, 0); PG8_LDB(B1, 0, 1); PG8_SCHED; PG8_LDA(At, 0, 0); PG8_STAGE(PG8_SA(1, 1), a1 + hA, voffA);
            PG8_WAIT_V(8); PG8_WAIT_L(0); PG8_BAR; PG8_MMA(0, 0, At, B0); PG8_MMA(0, 1, At, B1); PG8_BAR; PG8_SCHED;
            PG8_LDA(At, 0, 1); PG8_STAGE(PG8_SB(0, 0), b2, voffB); PG8_STAGE(PG8_SB(0, 1), b2 + hB, voffB); PG8_STAGE(PG8_SA(0, 0), a2, voffA);
            PG8_WAIT_V(8); PG8_WAIT_L(0); PG8_BAR; PG8_MMA(1, 0, At, B0); PG8_MMA(1, 1, At, B1); PG8_BAR; PG8_SCHED;
            PG8_LDB(B0, 1, 0); PG8_LDB(B1, 1, 1); PG8_SCHED; PG8_LDA(At, 1, 0); PG8_STAGE(PG8_SA(0, 1), a2 + hA, voffA);
            PG8_WAIT_V(8); PG8_WAIT_L(0); PG8_BAR; PG8_MMA(0, 0, At, B0); PG8_MMA(0, 1, At, B1); PG8_BAR; PG8_SCHED;
            PG8_LDA(At, 1, 1); PG8_STAGE(PG8_SB(1, 0), b3, voffB); PG8_STAGE(PG8_SB(1, 1), b3 + hB, voffB); PG8_STAGE(PG8_SA(1, 0), a3, voffA);
            PG8_WAIT_V(8); PG8_WAIT_L(0); PG8_BAR; PG8_MMA(1, 0, At, B0); PG8_MMA(1, 1, At, B1); PG8_BAR; PG8_SCHED;
        }
        if constexpr (ALIGN_EPI) { if (wr == 0) PG8_BAR; }
        E(acc, cur, wr, wc, fr, fq);
        if (!has_next) break;
#pragma unroll
        for (int a = 0; a < 2; ++a)
#pragma unroll
            for (int b = 0; b < 2; ++b)
#pragma unroll
                for (int m = 0; m < 4; ++m)
#pragma unroll
                    for (int n = 0; n < 2; ++n) acc[a][b][m][n] = (f32x4){0.f, 0.f, 0.f, 0.f};
        cur = nxt; cA = nA; cB = nB; ++ui;
        if constexpr (ALIGN_EPI) { if (wr == 1) PG8_BAR; }
    }
    PG8_WAIT_V(0);
    if constexpr (!ALIGN_EPI) { if (wr == 0) PG8_BAR; }
    PG8_BAR;
#undef PG8_SA
#undef PG8_SB
#undef PG8_STAGE
#undef PG8_LDA
#undef PG8_LDB
#undef PG8_MMA
#undef PG8_WAIT_V
#undef PG8_WAIT_L
#undef PG8_BAR
#undef PG8_SCHED
}

template <class E> DI void epi_rows_scaled(const E& e, const float* rs, const Acc& acc, const Unit& u, int wr, int wc, int fr, int fq) {
    float r[2][4];
#pragma unroll
    for (int ai = 0; ai < 2; ++ai)
#pragma unroll
        for (int m = 0; m < 4; ++m) r[ai][m] = rstd_of(rs, u.pm * 256 + ai * 128 + wr * 64 + m * 16 + fr);
#pragma unroll
    for (int ai = 0; ai < 2; ++ai)
#pragma unroll
        for (int m = 0; m < 4; ++m)
#pragma unroll
            for (int bj = 0; bj < 2; ++bj) {
                const int row = u.pm * 256 + ai * 128 + wr * 64 + m * 16 + fr; const int col0 = u.pn * 256 + bj * 128 + wc * 32 + 8 * fq;
                e.row8(u.z, row, col0, acc[ai][bj][m][0] * r[ai][m], acc[ai][bj][m][1] * r[ai][m]);
            }
}
template <class E> DI void epi_rows(const E& e, const Acc& acc, const Unit& u, int wr, int wc, int fr, int fq) {
#pragma unroll
    for (int ai = 0; ai < 2; ++ai)
#pragma unroll
        for (int m = 0; m < 4; ++m)
#pragma unroll
            for (int bj = 0; bj < 2; ++bj) {
                const int row = u.pm * 256 + ai * 128 + wr * 64 + m * 16 + fr; const int col0 = u.pn * 256 + bj * 128 + wc * 32 + 8 * fq;
                e.row8(u.z, row, col0, acc[ai][bj][m][0], acc[ai][bj][m][1]);
            }
}
struct EpiStore {
    bf16_t* O; int ldc; long sOz; const float* rs; const float* cs;
    DI void row8(int z, int row, int col0, f32x4 v0, f32x4 v1) const {
        if (cs) { const f32x4 s0 = *(const f32x4*)(cs + col0), s1 = *(const f32x4*)(cs + col0 + 4);
#pragma unroll
            for (int i = 0; i < 4; ++i) { v0[i] *= rsqrtf(s0[i] * (1.f / D) + EPS); v1[i] *= rsqrtf(s1[i] * (1.f / D) + EPS); } }
        *(u32x4*)(O + (size_t)z * sOz + (size_t)row * ldc + col0) = pack8(v0, v1); }
    DI void naive(const Unit& u, int row, int wc, int fq, const f32x4 a0, const f32x4 a1, const f32x4 b0, const f32x4 b1) const { row8(u.z, row, u.pn * 256 + wc * 32 + 8 * fq, a0, a1); row8(u.z, row, u.pn * 256 + 128 + wc * 32 + 8 * fq, b0, b1); }
    DI void operator()(const Acc& acc, const Unit& u, int wr, int wc, int fr, int fq) const { if (rs) epi_rows_scaled(*this, rs, acc, u, wr, wc, fr, fq); else epi_rows(*this, acc, u, wr, wc, fr, fq); }
};
struct EpiInProj {
    bf16_t* Ug; bf16_t* Big; float* Logits; const float* rs;
    DI void row8(int z, int row, int col0, const f32x4 v0, const f32x4 v1) const {
        if (col0 < 512) { const int g = col0 >> 4, c = col0 & 15, b = row >> 11, s = row & 2047, n = s >> 5, j = s & 31;
            *(u32x4*)(Ug + ((size_t)(g * S5ROWS + b * S5NCH + n)) * S5K + j * 16 + c) = pack8(v0, v1); }
        else if (col0 < 2560) { *(u32x4*)(Big + (size_t)row * ABPAD + col0) = pack8(v0, v1); }
        else if (col0 == 2560) { *(f32x4*)(Logits + (size_t)row * 8) = v0; *(f32x4*)(Logits + (size_t)row * 8 + 4) = v1; }
    }
    DI void naive(const Unit& u, int row, int wc, int fq, const f32x4 a0, const f32x4 a1, const f32x4 b0, const f32x4 b1) const { row8(u.z, row, u.pn * 256 + wc * 32 + 8 * fq, a0, a1); row8(u.z, row, u.pn * 256 + 128 + wc * 32 + 8 * fq, b0, b1); }
    DI void operator()(const Acc& acc, const Unit& u, int wr, int wc, int fr, int fq) const { epi_rows_scaled(*this, rs, acc, u, wr, wc, fr, fq); }
};
struct EpiResid {
    bf16_t* XB; float* OutF; float* PSn; LAS float* part;
    DI void operator()(const Acc& acc, const Unit& u, int wr, int wc, int fr, int fq) const {
#pragma unroll
        for (int ai = 0; ai < 2; ++ai)
#pragma unroll
            for (int m = 0; m < 4; ++m) {
                const int row = u.pm * 256 + ai * 128 + wr * 64 + m * 16 + fr; float s = 0.f;
#pragma unroll
                for (int bj = 0; bj < 2; ++bj) { const int col0 = u.pn * 256 + bj * 128 + wc * 32 + 8 * fq;
                    bf16_t* p = XB + (size_t)row * D + col0; float xv[8]; unpack8(*(const u32x4*)p, xv);
                    const f32x4 a = (f32x4){xv[0], xv[1], xv[2], xv[3]} + acc[ai][bj][m][0], b = (f32x4){xv[4], xv[5], xv[6], xv[7]} + acc[ai][bj][m][1];
                    if (OutF) { float* o = OutF + (size_t)row * D + col0; *(f32x4*)o = a; *(f32x4*)(o + 4) = b; } else *(u32x4*)p = pack8(a, b);
                    s += (a[0] * a[0] + a[1] * a[1]) + (a[2] * a[2] + a[3] * a[3]) + (b[0] * b[0] + b[1] * b[1]) + (b[2] * b[2] + b[3] * b[3]); }
                s += __shfl_xor(s, 16); s += __shfl_xor(s, 32);
                if (fq == 0) part[(ai * 128 + wr * 64 + m * 16 + fr) * 4 + wc] = s;
            }
        asm volatile("s_waitcnt lgkmcnt(0)" ::: "memory"); __builtin_amdgcn_s_barrier(); asm volatile("" ::: "memory");
        if (PSn) { const int t = threadIdx.x; if (t < 256) { const f32x4 p4 = *(const LAS f32x4*)(part + t * 4); PSn[(size_t)(u.pm * 256 + t) * 4 + u.pn] = (p4[0] + p4[1]) + (p4[2] + p4[3]); } }
        asm volatile("s_waitcnt lgkmcnt(0)" ::: "memory"); __builtin_amdgcn_s_barrier(); asm volatile("" ::: "memory");
    }
    DI void naive(const Unit& u, int row, int wc, int fq, const f32x4 a0, const f32x4 a1, const f32x4 b0, const f32x4 b1) const { }
};
struct EpiSwiglu {
    bf16_t* H; const float* rs;
    DI void naive(const Unit& u, int row, int wc, int fq, const f32x4 a0, const f32x4 a1, const f32x4 b0, const f32x4 b1) const {
        const int hid = u.pn * 128 + wc * 32 + 8 * fq; f32x4 h0, h1;
#pragma unroll
        for (int i = 0; i < 4; ++i) { h0[i] = siluf_(a0[i]) * b0[i]; h1[i] = siluf_(a1[i]) * b1[i]; }
        *(u32x4*)(H + (size_t)row * FF + hid) = pack8(h0, h1);
    }
    DI void operator()(const Acc& acc, const Unit& u, int wr, int wc, int fr, int fq) const {
        float rr[2][4];
#pragma unroll
        for (int ai = 0; ai < 2; ++ai)
#pragma unroll
            for (int m = 0; m < 4; ++m) rr[ai][m] = rstd_of(rs, u.pm * 256 + ai * 128 + wr * 64 + m * 16 + fr);
#pragma unroll
        for (int ai = 0; ai < 2; ++ai)
#pragma unroll
            for (int m = 0; m < 4; ++m) {
                const int row = u.pm * 256 + ai * 128 + wr * 64 + m * 16 + fr; const int hid = u.pn * 128 + wc * 32 + 8 * fq; const float r = rr[ai][m];
                f32x4 h0, h1;
#pragma unroll
                for (int i = 0; i < 4; ++i) { h0[i] = siluf_(acc[ai][0][m][0][i] * r) * acc[ai][1][m][0][i] * r; h1[i] = siluf_(acc[ai][0][m][1][i] * r) * acc[ai][1][m][1][i] * r; }
                *(u32x4*)(H + (size_t)row * FF + hid) = pack8(h0, h1);
            }
    }
};
struct EpiS5State {
    float* S;
    DI void row8(int z, int row, int col0, const f32x4 v0, const f32x4 v1) const { if (col0 < 128) { float* p = S + ((size_t)z * S5ROWS + row) * 128 + col0; *(f32x4*)p = v0; *(f32x4*)(p + 4) = v1; } }
    DI void naive(const Unit& u, int row, int wc, int fq, const f32x4 a0, const f32x4 a1, const f32x4 b0, const f32x4 b1) const { row8(u.z, row, u.pn * 256 + wc * 32 + 8 * fq, a0, a1); row8(u.z, row, u.pn * 256 + 128 + wc * 32 + 8 * fq, b0, b1); }
    DI void operator()(const Acc& acc, const Unit& u, int wr, int wc, int fr, int fq) const { epi_rows(*this, acc, u, wr, wc, fr, fq); }
};
struct EpiS5Y {
    const bf16_t* Ug; const float* dvec; bf16_t* Big;
    DI void row8(int z, int row, int col0, const f32x4 v0, const f32x4 v1) const {
        const int t = col0 >> 4, c = col0 & 15; const int token = (row >> 6) * SEQ + (row & 63) * S5L + t;
        const u32x4 uw = *(const u32x4*)(Ug + ((size_t)z * S5ROWS + row) * S5K + t * 16 + c); float uu[8]; unpack8(uw, uu);
        const f32x4 d0 = *(const f32x4*)(dvec + z * 16 + c); const f32x4 d1 = *(const f32x4*)(dvec + z * 16 + c + 4);
        f32x4 y0, y1;
#pragma unroll
        for (int i = 0; i < 4; ++i) { const float k_ = (DBG_SKIP & 32) ? 0.f : 1.f; y0[i] = gelu_tanh(k_ * v0[i] + d0[i] * uu[i]); y1[i] = gelu_tanh(k_ * v1[i] + d1[i] * uu[4 + i]); }
        *(u32x4*)(Big + (size_t)token * ABPAD + z * 16 + c) = pack8(y0, y1);
    }
    DI void naive(const Unit& u, int row, int wc, int fq, const f32x4 a0, const f32x4 a1, const f32x4 b0, const f32x4 b1) const { row8(u.z, row, u.pn * 256 + wc * 32 + 8 * fq, a0, a1); row8(u.z, row, u.pn * 256 + 128 + wc * 32 + 8 * fq, b0, b1); }
    DI void operator()(const Acc& acc, const Unit& u, int wr, int wc, int fr, int fq) const { epi_rows(*this, acc, u, wr, wc, fr, fq); }
};
struct EpiGlu {
    const bf16_t* Big; const float* bias; bf16_t* Mix;
    DI void row8(int z, int row, int col0, const f32x4 v0, const f32x4 v1) const {
        const u32x4 hw = *(const u32x4*)(Big + (size_t)row * ABPAD + col0); float hh[8]; unpack8(hw, hh);
        const f32x4 b0 = *(const f32x4*)(bias + col0); const f32x4 b1 = *(const f32x4*)(bias + col0 + 4);
        f32x4 o0, o1;
#pragma unroll
        for (int i = 0; i < 4; ++i) { o0[i] = hh[i] * sigmoidf_(v0[i] + b0[i]); o1[i] = hh[4 + i] * sigmoidf_(v1[i] + b1[i]); }
        if (DBG_SKIP & 4) { o0 = (f32x4){0.f,0.f,0.f,0.f}; o1 = o0; }
        if (DBG_HALF & 4) { o0 = o0 * DBG_A; o1 = o1 * DBG_A; }
        *(u32x4*)(Mix + (size_t)row * D + col0) = pack8(o0, o1);
    }
    DI void naive(const Unit& u, int row, int wc, int fq, const f32x4 a0, const f32x4 a1, const f32x4 b0, const f32x4 b1) const { row8(u.z, row, u.pn * 256 + wc * 32 + 8 * fq, a0, a1); row8(u.z, row, u.pn * 256 + 128 + wc * 32 + 8 * fq, b0, b1); }
    DI void operator()(const Acc& acc, const Unit& u, int wr, int wc, int fr, int fq) const { epi_rows(*this, acc, u, wr, wc, fr, fq); }
};
}

struct Ctx { LAS unsigned char* lds; int tid, lane, wave, gw, ngw; };
DI Ctx make_ctx(LAS unsigned char* lds) {
    Ctx C; int t = threadIdx.x; asm volatile("" : "+v"(t));
    C.lds = lds; C.tid = t; C.lane = t & 63; C.wave = __builtin_amdgcn_readfirstlane(t >> 6);
    C.gw = blockIdx.x * NWAVES + C.wave; C.ngw = gridDim.x * NWAVES; return C;
}

DI void tr_item(const float* W, int K, int N, int ldw, int n_off, bf16_t* WT, int row_off, int grp, int gstride, LAS float* scr, int item, int lane, const float* gain = nullptr) {
    const int nblk = (N + 31) / 32, kb = item / nblk, nb = item % nblk, k0 = 64 * kb, n0 = 32 * nb;
    const int rr = lane >> 3, cc = (lane & 7) * 4; const bool ok = (n0 + cc) < N;
    f32x4 v[8];
#pragma unroll
    for (int i = 0; i < 8; ++i) { const f32x4 t4 = *(const f32x4*)(W + (size_t)(k0 + 8 * i + rr) * ldw + n_off + n0 + (ok ? cc : 0)); v[i] = ok ? t4 : (f32x4){0.f, 0.f, 0.f, 0.f}; }
#pragma unroll
    for (int i = 0; i < 8; ++i) { const int kk = 8 * i + rr; const float gk = gain ? gain[k0 + kk] : 1.f; LAS float* sp = scr + kk * 33 + cc; sp[0] = v[i][0] * gk; sp[1] = v[i][1] * gk; sp[2] = v[i][2] * gk; sp[3] = v[i][3] * gk; }
    asm volatile("s_waitcnt lgkmcnt(0)" ::: "memory");
    const int c = lane & 7;
#pragma unroll
    for (int j = 0; j < 4; ++j) { const int n = (lane >> 3) + 8 * j; const LAS float* s = scr + (8 * c) * 33 + n;
        u32x4 o; o.x = cvt_pk_bf16(s[0 * 33], s[1 * 33]); o.y = cvt_pk_bf16(s[2 * 33], s[3 * 33]); o.z = cvt_pk_bf16(s[4 * 33], s[5 * 33]); o.w = cvt_pk_bf16(s[6 * 33], s[7 * 33]);
        const int q = n0 + n; const int drow = row_off + (q / grp) * gstride + (q % grp);
        *(u32x4*)(WT + (size_t)drow * K + k0 + 8 * c) = o; }
    asm volatile("s_waitcnt lgkmcnt(0)" ::: "memory");
}
DI void conv_mat(const Ctx& C, const float* W, int K, int N, int ldw, int n_off, bf16_t* WT, int row_off, int grp, int gstride) {
#if DBG_NAIVE
    { const size_t tot = (size_t)K * N; const size_t stride = (size_t)C.ngw * 64;
      for (size_t idx = (size_t)C.gw * 64 + C.lane; idx < tot; idx += stride) { const int n = (int)(idx / K), k = (int)(idx % K);
          const int drow = row_off + (n / grp) * gstride + (n % grp); WT[(size_t)drow * K + k] = f2bf(W[(size_t)k * ldw + n_off + n]); }
      return; }
#endif
    LAS float* scr = (LAS float*)(C.lds + C.wave * 16384);
    const int items = (K / 64) * ((N + 31) / 32);
    for (int it = C.gw; it < items; it += C.ngw) tr_item(W, K, N, ldw, n_off, WT, row_off, grp, gstride, scr, it, C.lane);
}
DI void rms_rows(const Ctx& C, const float* X, const float* gain, bf16_t* O, int rows) {
#if DBG_NAIVE
    { const int gt = C.gw * 64 + C.lane, nth = C.ngw * 64;
      for (int r = gt; r < rows; r += nth) { const float* xr = X + (size_t)r * D; float s = 0.f; for (int k = 0; k < D; ++k) s += xr[k] * xr[k];
          const float rstd = 1.0f / sqrtf(s / (float)D + EPS); for (int k = 0; k < D; ++k) O[(size_t)r * D + k] = f2bf(xr[k] * rstd * gain[k]); }
      return; }
#endif
    const f32x4 g0 = *(const f32x4*)(gain + 4 * C.lane), g1 = *(const f32x4*)(gain + 256 + 4 * C.lane), g2 = *(const f32x4*)(gain + 512 + 4 * C.lane), g3 = *(const f32x4*)(gain + 768 + 4 * C.lane);
    for (int r = C.gw; r < rows; r += C.ngw) {
        const f32x4* xr = (const f32x4*)(X + (size_t)r * D) + C.lane;
        f32x4 v0 = xr[0], v1 = xr[64], v2 = xr[128], v3 = xr[192];
        float s = (v0[0]*v0[0] + v0[1]*v0[1]) + (v0[2]*v0[2] + v0[3]*v0[3]) + (v1[0]*v1[0] + v1[1]*v1[1]) + (v1[2]*v1[2] + v1[3]*v1[3])
                + (v2[0]*v2[0] + v2[1]*v2[1]) + (v2[2]*v2[2] + v2[3]*v2[3]) + (v3[0]*v3[0] + v3[1]*v3[1]) + (v3[2]*v3[2] + v3[3]*v3[3]);
        const float rstd = rsqrtf(wave_sum(s) * (1.f / D) + EPS);
        v0 = v0 * rstd * g0; v1 = v1 * rstd * g1; v2 = v2 * rstd * g2; v3 = v3 * rstd * g3;
        u32x2* o = (u32x2*)(O + (size_t)r * D) + C.lane;
        o[0]   = (u32x2){cvt_pk_bf16(v0[0], v0[1]), cvt_pk_bf16(v0[2], v0[3])};
        o[64]  = (u32x2){cvt_pk_bf16(v1[0], v1[1]), cvt_pk_bf16(v1[2], v1[3])};
        o[128] = (u32x2){cvt_pk_bf16(v2[0], v2[1]), cvt_pk_bf16(v2[2], v2[3])};
        o[192] = (u32x2){cvt_pk_bf16(v3[0], v3[1]), cvt_pk_bf16(v3[2], v3[3])};
    }
}
DI void rms_rows_b(const Ctx& C, const bf16_t* Xb, const float* gain, bf16_t* O, int rows) {
    f32x4 g[4];
#pragma unroll
    for (int j = 0; j < 4; ++j) g[j] = *(const f32x4*)(gain + 256 * j + 4 * C.lane);
    for (int r = C.gw; r < rows; r += C.ngw) {
        const u32x2* xr = (const u32x2*)(Xb + (size_t)r * D) + C.lane; f32x4 v[4]; float s = 0.f;
#pragma unroll
        for (int j = 0; j < 4; ++j) { const u32x2 w = xr[64 * j]; v[j] = (f32x4){bflo(w.x), bfhi(w.x), bflo(w.y), bfhi(w.y)}; s += (v[j][0] * v[j][0] + v[j][1] * v[j][1]) + (v[j][2] * v[j][2] + v[j][3] * v[j][3]); }
        const float rstd = rsqrtf(wave_sum(s) * (1.f / D) + EPS);
        u32x2* o = (u32x2*)(O + (size_t)r * D) + C.lane;
#pragma unroll
        for (int j = 0; j < 4; ++j) { const f32x4 y = v[j] * rstd * g[j]; o[64 * j] = (u32x2){cvt_pk_bf16(y[0], y[1]), cvt_pk_bf16(y[2], y[3])}; }
    }
}
DI void x_prep(const Ctx& C, const float* Xin, bf16_t* XB, float* PS0) {
    for (int r = C.gw; r < M; r += C.ngw) {
        const f32x4* xr = (const f32x4*)(Xin + (size_t)r * D) + C.lane; u32x2* xb = (u32x2*)(XB + (size_t)r * D) + C.lane; float s = 0.f;
#pragma unroll
        for (int j = 0; j < 4; ++j) { const f32x4 v = xr[64 * j]; xb[64 * j] = (u32x2){cvt_pk_bf16(v[0], v[1]), cvt_pk_bf16(v[2], v[3])}; s += (v[0] * v[0] + v[1] * v[1]) + (v[2] * v[2] + v[3] * v[3]); }
        s = wave_sum(s); if (C.lane < 4) PS0[(size_t)r * 4 + C.lane] = C.lane == 0 ? s : 0.f;
    }
}
DI void copy_f32(const Ctx& C, const float* src, float* dst, size_t n4) {
    const size_t stride = (size_t)C.ngw * 64;
    for (size_t i = (size_t)C.gw * 64 + C.lane; i < n4; i += stride) ((f32x4*)dst)[i] = ((const f32x4*)src)[i];
}
DI void knorm_phase(const Ctx& C, bf16_t* KALL, const float* kg  ) {
    for (int r = C.gw; r < MMEM * 16; r += C.ngw) {
        const int tok = r >> 4, lh = r & 15, layer = lh >> 2;
        u32x2* p = (u32x2*)(KALL + (size_t)tok * 4096 + lh * 256) + C.lane;
        const u32x2 w = *p; float v0 = bflo(w.x), v1 = bfhi(w.x), v2 = bflo(w.y), v3 = bfhi(w.y);
        const float rstd = rsqrtf(wave_sum(v0 * v0 + v1 * v1 + v2 * v2 + v3 * v3) * (1.f / 256.f) + EPS);
        const f32x4 g = *(const f32x4*)(kg + layer * 256 + 4 * C.lane);
        *p = (u32x2){cvt_pk_bf16(v0 * rstd * g[0], v1 * rstd * g[1]), cvt_pk_bf16(v2 * rstd * g[2], v3 * rstd * g[3])};
    }
}

DI void s5_build(const Ctx& C, const float* a_re, const float* a_im, const float* log_dt, const float* b_re, const float* b_im, const float* c_re, const float* c_im, bf16_t* T, bf16_t* Bm) {
    LAS float* lamr = (LAS float*)C.lds; LAS float* lami = lamr + 64; LAS float* Bre = lami + 64; LAS float* Bim = Bre + 1024; LAS float* Cre = Bim + 1024; LAS float* Cim = Cre + 1024;
    LAS unsigned short* Kd = (LAS unsigned short*)(Cim + 1024);
    for (int u = blockIdx.x; u < 32 * 8; u += gridDim.x) {
        const int g = u >> 3, part = u & 7, tlo = part * 4;
        __syncthreads();
        const float dt = __expf(log_dt[g]);
        if (C.tid < 64) { const int p = C.tid; const float ar = a_re[g * 64 + p], ai = a_im[g * 64 + p]; float sn, cs; sincosf(ai * dt, &sn, &cs); const float mag = __expf(ar * dt); lamr[p] = mag * cs; lami[p] = mag * sn; }
        for (int e = C.tid; e < 1024; e += NTHR) { Cre[e] = c_re[(size_t)g * 1024 + e]; Cim[e] = c_im[(size_t)g * 1024 + e]; }
        __syncthreads();
        for (int e = C.tid; e < 1024; e += NTHR) { const int p = e >> 4; const float ar = a_re[g * 64 + p], ai = a_im[g * 64 + p];
            const float nr = lamr[p] - 1.f, ni = lami[p]; const float inv = 1.f / (ar * ar + ai * ai);
            const float qr = (nr * ar + ni * ai) * inv, qi = (ni * ar - nr * ai) * inv;
            const float br = b_re[(size_t)g * 1024 + e], bi = b_im[(size_t)g * 1024 + e];
            Bre[e] = qr * br - qi * bi; Bim[e] = qr * bi + qi * br; }
        __syncthreads();
        for (int pass = 0; pass < 2; ++pass) { const int entry = pass * 128 + (C.tid >> 2), qt = C.tid & 3, c = entry >> 4, cp = entry & 15;
          float wr_[16], wi_[16];
#pragma unroll
          for (int k = 0; k < 16; ++k) { const int p = 16 * qt + k; wr_[k] = Bre[p * 16 + cp]; wi_[k] = Bim[p * 16 + cp]; }
          for (int dl = 0; dl <= tlo + 3; ++dl) {
              float s = 0.f;
#pragma unroll
              for (int k = 0; k < 16; ++k) { const int p = 16 * qt + k; s += Cre[c * 64 + p] * wr_[k] - Cim[c * 64 + p] * wi_[k];
                  const float nr = wr_[k] * lamr[p] - wi_[k] * lami[p], ni = wr_[k] * lami[p] + wi_[k] * lamr[p]; wr_[k] = nr; wi_[k] = ni; }
              s += __shfl_xor(s, 1); s += __shfl_xor(s, 2);
              if (qt == 0) Kd[dl * 256 + entry] = f2bf(s);
          } }
        __syncthreads();
        for (int idx = C.tid; idx < 4 * 16 * 64; idx += NTHR) { const int hf = idx & 1, j = (idx >> 1) & 31, c = (idx >> 6) & 15, t = tlo + (idx >> 10);
            u32x4 w = (u32x4){0u, 0u, 0u, 0u}; if (j <= t) w = *(const LAS u32x4*)(Kd + (t - j) * 256 + c * 16 + hf * 8);
            *(u32x4*)(T + ((size_t)g * 512 + t * 16 + c) * S5K + j * 16 + hf * 8) = w; }
        for (int e = C.tid; e < 1024; e += NTHR) {
            { const int c = e >> 6, p = e & 63; float er = lamr[p], ei = lami[p];
              for (int k = 0; k < tlo; ++k) { const float nr = er * lamr[p] - ei * lami[p], ni = er * lami[p] + ei * lamr[p]; er = nr; ei = ni; }
              const float cr = Cre[e], ci = Cim[e];
              for (int t = tlo; t < tlo + 4; ++t) { *(unsigned*)(T + ((size_t)g * 512 + t * 16 + c) * S5K + 512 + 2 * p) = cvt_pk_bf16(cr * er - ci * ei, -(cr * ei + ci * er));
                  const float nr = er * lamr[p] - ei * lami[p], ni = er * lami[p] + ei * lamr[p]; er = nr; ei = ni; } }
            { const int p = e >> 4, cp = e & 15; float er = 1.f, ei = 0.f;
              for (int k = 0; k < 31 - (tlo + 3); ++k) { const float nr = er * lamr[p] - ei * lami[p], ni = er * lami[p] + ei * lamr[p]; er = nr; ei = ni; }
              const float br = Bre[e], bi = Bim[e];
              for (int j = tlo + 3; j >= tlo; --j) { Bm[((size_t)g * 256 + 2 * p) * 512 + j * 16 + cp] = f2bf(er * br - ei * bi); Bm[((size_t)g * 256 + 2 * p + 1) * 512 + j * 16 + cp] = f2bf(er * bi + ei * br);
                  const float nr = er * lamr[p] - ei * lami[p], ni = er * lami[p] + ei * lamr[p]; er = nr; ei = ni; } }
        }
    }
    __syncthreads();
}
DI void s5_scan(const Ctx& C, const float* a_re, const float* a_im, const float* log_dt, const float* S, bf16_t* Ug) {
    const int gt = blockIdx.x * NTHR + C.tid;
    if (gt < BATCH * 32 * 64) {
        const int p = gt & 63, g = (gt >> 6) & 31, b = gt >> 11;
        const float dt = __expf(log_dt[g]); const float ar = a_re[g * 64 + p], ai = a_im[g * 64 + p];
        float sn, cs; sincosf(ai * dt * 32.f, &sn, &cs); const float mag = __expf(ar * dt * 32.f); const float lr = mag * cs, li = mag * sn;
        float xr = 0.f, xi = 0.f;
        const size_t row0 = (size_t)g * S5ROWS + b * S5NCH;
        for (int nb = 0; nb < S5NCH; nb += 32) {
            f32x2 sv[32];
#pragma unroll
            for (int j = 0; j < 32; ++j) sv[j] = *(const f32x2*)(S + (row0 + nb + j) * 128 + 2 * p);
#pragma unroll
            for (int j = 0; j < 32; ++j) {
                *(unsigned*)(Ug + (row0 + nb + j) * S5K + 512 + 2 * p) = cvt_pk_bf16(xr, xi);
                const float nr = lr * xr - li * xi + sv[j][0], ni = lr * xi + li * xr + sv[j][1]; xr = nr; xi = ni;
            }
        }
    }
}

DI void gdn_pre(const Ctx& C, const bf16_t* Big, const float* Logits, const float* conv_w  , const float* a_log, const float* dt_bias, unsigned char* scr, unsigned char* hn) {
    constexpr int LD = 129;
    constexpr int LB = 136;
    LAS float* kf = (LAS float*)C.lds; LAS float* vf = kf + 64 * LD; LAS float* qf = vf + 64 * LD; LAS float* Lm = qf;
    LAS bf16_t* qb = (LAS bf16_t*)(qf + 64 * LD); LAS bf16_t* kb = qb + 64 * LB; LAS float* gc = (LAS float*)(kb + 64 * LB); LAS float* be = gc + 64;
    bf16_t* WK = (bf16_t*)(hn + HN_WK); bf16_t* UT = (bf16_t*)(scr + SC_UT); bf16_t* QG = (bf16_t*)(scr + SC_QG); bf16_t* KT = (bf16_t*)(hn + HN_KT); bf16_t* QK = (bf16_t*)(scr + SC_QK); float* DEC = (float*)(scr + SC_DEC);
    for (int u = blockIdx.x; u < BATCH * 4 * 32; u += gridDim.x) {
        const int b = u >> 7, h = (u >> 5) & 3, n = u & 31; const int tok0 = b * SEQ + n * 64;
        __syncthreads();
        { const int d = C.tid & 127, tq = C.tid >> 7, t0 = tq * 16; const int s0 = n * 64 + t0;
          float xin[3][19];
#pragma unroll
          for (int part = 0; part < 3; ++part) { const bf16_t* src = Big + 512 + part * 512 + h * 128 + d;
#pragma unroll
              for (int i = 0; i < 19; ++i) { const int si = s0 - 3 + i, sc_ = si < 0 ? 0 : si; const float xv = bf2f(src[(size_t)(b * SEQ + sc_) * ABPAD]); xin[part][i] = si < 0 ? 0.f : xv; } }
#pragma unroll
          for (int part = 0; part < 3; ++part) {
              const int ch = part * 512 + h * 128 + d; const float w0 = conv_w[ch], w1 = conv_w[1536 + ch], w2 = conv_w[2 * 1536 + ch], w3 = conv_w[3 * 1536 + ch];
              LAS float* dst = part == 0 ? qf : (part == 1 ? kf : vf);
#pragma unroll
              for (int i = 0; i < 16; ++i) { const float y = w0 * xin[part][i] + w1 * xin[part][i + 1] + w2 * xin[part][i + 2] + w3 * xin[part][i + 3]; dst[(t0 + i) * LD + d] = siluf_(y); }
          } }
        if (C.wave == 0) { const int t = C.lane; const float a = Logits[(size_t)(tok0 + t) * 8 + h], bl = Logits[(size_t)(tok0 + t) * 8 + 4 + h];
            const float x = a + dt_bias[h]; const float sp = x > 20.f ? x : log1pf(__expf(x)); float gv = -__expf(a_log[h]) * sp;
#pragma unroll
            for (int o = 1; o < 64; o <<= 1) { const float y = __shfl_up(gv, o); if (t >= o) gv += y; }
            gc[t] = gv; be[t] = sigmoidf_(bl); }
        __syncthreads();
        for (int r = C.wave; r < 128; r += NWAVES) { LAS float* rowp = (r < 64 ? qf + r * LD : kf + (r - 64) * LD); const float v0 = rowp[C.lane], v1 = rowp[C.lane + 64];
            const float sc = rsqrtf(wave_sum(v0 * v0 + v1 * v1) + EPS) * (r < 64 ? 0.08838834764831845f : 1.f); rowp[C.lane] = v0 * sc; rowp[C.lane + 64] = v1 * sc;
            LAS bf16_t* bp = (r < 64 ? qb + r * LB : kb + (r - 64) * LB); bp[C.lane] = f2bf(v0 * sc); bp[C.lane + 64] = f2bf(v1 * sc); }
        __syncthreads();
        { const int w = C.wave, mt = w >> 1, l15 = C.lane & 15, lq = C.lane >> 4;
          f32x4 akk[2], aqk[2];
#pragma unroll
          for (int q2 = 0; q2 < 2; ++q2) { akk[q2] = (f32x4){0.f, 0.f, 0.f, 0.f}; aqk[q2] = akk[q2]; }
#pragma unroll
          for (int ks = 0; ks < 4; ++ks) { const bf16x8 af = *(const LAS bf16x8*)(kb + (16 * mt + l15) * LB + 32 * ks + 8 * lq);
#pragma unroll
              for (int q2 = 0; q2 < 2; ++q2) { const int nt = (w & 1) * 2 + q2;
                  const bf16x8 bk = *(const LAS bf16x8*)(kb + (16 * nt + l15) * LB + 32 * ks + 8 * lq), bq = *(const LAS bf16x8*)(qb + (16 * nt + l15) * LB + 32 * ks + 8 * lq);
                  akk[q2] = __builtin_amdgcn_mfma_f32_16x16x32_bf16(af, bk, akk[q2], 0, 0, 0); aqk[q2] = __builtin_amdgcn_mfma_f32_16x16x32_bf16(af, bq, aqk[q2], 0, 0, 0); } }
          __syncthreads();
#pragma unroll
          for (int q2 = 0; q2 < 2; ++q2) { const int nt = (w & 1) * 2 + q2;
              { const int j = 16 * nt + l15; const float gj = gc[j]; f32x4 lv;
#pragma unroll
                for (int i = 0; i < 4; ++i) { const int t = 16 * mt + 4 * lq + i; lv[i] = (t > j) ? be[t] * akk[q2][i] * __expf(gc[t] - gj) : 0.f; }
                *(LAS f32x4*)(Lm + j * 64 + 16 * mt + 4 * lq) = lv; }
              { const int t = 16 * nt + l15; const float gt_ = gc[t]; f32x4 qv;
#pragma unroll
                for (int i = 0; i < 4; ++i) { const int j = 16 * mt + 4 * lq + i; qv[i] = (t >= j) ? aqk[q2][i] * __expf(gt_ - gc[j]) : 0.f; }
                *(u32x2*)(QK + (size_t)u * 4096 + t * 64 + 16 * mt + 4 * lq) = (u32x2){cvt_pk_bf16(qv[0], qv[1]), cvt_pk_bf16(qv[2], qv[3])}; } } }
        __syncthreads();
        { const float glast = gc[63];
          for (int e = C.tid; e < 64 * 16; e += NTHR) { const int t = e >> 4, d0 = (e & 15) * 8; const float gm = __expf(gc[t]); f32x4 a, b2;
#pragma unroll
              for (int i = 0; i < 4; ++i) { a[i] = bf2f(qb[t * LB + d0 + i]) * gm; b2[i] = bf2f(qb[t * LB + d0 + 4 + i]) * gm; }
              *(u32x4*)(QG + (size_t)u * 8192 + t * 128 + d0) = pack8(a, b2); }
          for (int e = C.tid; e < 128 * 8; e += NTHR) { const int d = e >> 3, t0 = (e & 7) * 8; f32x4 a, b2;
#pragma unroll
              for (int i = 0; i < 4; ++i) { a[i] = kf[(t0 + i) * LD + d] * __expf(glast - gc[t0 + i]); b2[i] = kf[(t0 + 4 + i) * LD + d] * __expf(glast - gc[t0 + 4 + i]); }
              *(u32x4*)(KT + (size_t)u * 8192 + d * 64 + t0) = pack8(a, b2); }
          if (C.tid == 0) DEC[u] = __expf(glast); }
        __syncthreads();
        if (C.tid < 256) {
            const int col = C.tid; LAS float* base = (col < 128) ? (vf + col) : (kf + (col - 128));
            for (int tb = 0; tb < 4; ++tb) {
                float acc[16];
#pragma unroll
                for (int i = 0; i < 16; ++i) { const int t = tb * 16 + i; const float sc = (col < 128) ? be[t] : be[t] * __expf(gc[t]); acc[i] = base[t * LD] * sc; }
                for (int j = 0; j < tb * 16; ++j) { const float s = base[j * LD]; const LAS f32x4* lp = (const LAS f32x4*)(Lm + j * 64 + tb * 16);
                    const f32x4 l0 = lp[0], l1 = lp[1], l2 = lp[2], l3 = lp[3];
#pragma unroll
                    for (int i = 0; i < 4; ++i) { acc[i] -= l0[i] * s; acc[4 + i] -= l1[i] * s; acc[8 + i] -= l2[i] * s; acc[12 + i] -= l3[i] * s; } }
#pragma unroll
                for (int j = 0; j < 15; ++j) { const float s = acc[j]; const LAS float* lp = Lm + (tb * 16 + j) * 64 + tb * 16;
#pragma unroll
                    for (int i = j + 1; i < 16; ++i) acc[i] -= lp[i] * s; }
#pragma unroll
                for (int i = 0; i < 16; ++i) base[(tb * 16 + i) * LD] = acc[i];
            }
        }
        __syncthreads();
        for (int e = C.tid; e < 128 * 8; e += NTHR) { const int ee = e >> 3, t0 = (e & 7) * 8;
            *(u32x4*)(UT + (size_t)u * 8192 + ee * 64 + t0) = pack8((f32x4){vf[t0 * LD + ee], vf[(t0 + 1) * LD + ee], vf[(t0 + 2) * LD + ee], vf[(t0 + 3) * LD + ee]}, (f32x4){vf[(t0 + 4) * LD + ee], vf[(t0 + 5) * LD + ee], vf[(t0 + 6) * LD + ee], vf[(t0 + 7) * LD + ee]}); }
        for (int e = C.tid; e < 64 * 16; e += NTHR) { const int t = e >> 4, d0 = (e & 15) * 8; f32x4 a, b2;
#pragma unroll
            for (int i = 0; i < 4; ++i) { a[i] = kf[t * LD + d0 + i]; b2[i] = kf[t * LD + d0 + 4 + i]; }
            *(u32x4*)(WK + (size_t)u * 8192 + t * 128 + d0) = pack8(a, b2); }
    }
    __syncthreads();
}
DI void gdn_seq(const Ctx& C, const unsigned char* scr, const unsigned char* hn, float* GO  ) {
    const bf16_t* WK = (const bf16_t*)(hn + HN_WK); const bf16_t* UT = (const bf16_t*)(scr + SC_UT); const bf16_t* QG = (const bf16_t*)(scr + SC_QG); const bf16_t* KT = (const bf16_t*)(hn + HN_KT); const bf16_t* QK = (const bf16_t*)(scr + SC_QK); const float* DEC = (const float*)(scr + SC_DEC);
    constexpr int STLD = 136, WTLD = 72;
    LAS bf16_t* ST = (LAS bf16_t*)C.lds; LAS bf16_t* WT = ST + 16 * STLD; LAS float* decs = (LAS float*)(WT + 16 * WTLD);
    const int w = C.wave, l15 = C.lane & 15, lq = C.lane >> 4;
    for (int blk = blockIdx.x; blk < BATCH * 4 * 8; blk += gridDim.x) {
        const int bh = blk >> 3, es = blk & 7, b = bh >> 2, h = bh & 3;
        f32x4 Sreg = (f32x4){0.f, 0.f, 0.f, 0.f};
        __syncthreads();
        *(LAS u32x2*)(ST + l15 * STLD + 16 * w + 4 * lq) = (u32x2){0u, 0u};
        if (C.tid < 32) { int idx = bh * 32 + C.tid; asm volatile("" : "+v"(idx)); decs[C.tid] = DEC[idx]; }
        __syncthreads();
        const int mt = w & 3;
        bf16x8 a1[4], a2[2], a3[2]; u32x2 uw = (u32x2){0u, 0u}; float dec = 0.f; a2[0] = (bf16x8){0, 0, 0, 0, 0, 0, 0, 0}; a2[1] = a2[0];
#define GS_LOAD(n_) do { const size_t u_ = (size_t)bh * 32 + (n_); \
            const bf16_t* As_ = (w < 4 ? WK : QG) + u_ * 8192 + (16 * mt + l15) * 128 + 8 * lq; \
            _Pragma("unroll") for (int ks = 0; ks < 4; ++ks) a1[ks] = *(const bf16x8*)(As_ + 32 * ks); \
            if (w >= 4) { _Pragma("unroll") for (int ks = 0; ks < 2; ++ks) a2[ks] = *(const bf16x8*)(QK + u_ * 4096 + (16 * mt + l15) * 64 + 32 * ks + 8 * lq); } \
            else uw = *(const u32x2*)(UT + u_ * 8192 + (es * 16 + l15) * 64 + 16 * mt + 4 * lq); \
            _Pragma("unroll") for (int ks = 0; ks < 2; ++ks) a3[ks] = *(const bf16x8*)(KT + u_ * 8192 + (16 * w + l15) * 64 + 32 * ks + 8 * lq); \
            dec = decs[(n_)]; } while (0)
        GS_LOAD(0);
        for (int n = 0; n < 32; ++n) {
            bf16x8 c1[4], c2[2], c3[2];
#pragma unroll
            for (int ks = 0; ks < 4; ++ks) c1[ks] = a1[ks];
#pragma unroll
            for (int ks = 0; ks < 2; ++ks) { c2[ks] = a2[ks]; c3[ks] = a3[ks]; }
            u32x2 cuw = uw; float cdec = dec;
#pragma unroll
            for (int ks = 0; ks < 4; ++ks) asm volatile("" : "+v"(c1[ks]));
#pragma unroll
            for (int ks = 0; ks < 2; ++ks) asm volatile("" : "+v"(c2[ks]), "+v"(c3[ks]));
            asm volatile("" : "+v"(cuw), "+v"(cdec));
            if (n + 1 < 32) GS_LOAD(n + 1);
            f32x4 acc = (f32x4){0.f, 0.f, 0.f, 0.f};
#pragma unroll
            for (int ks = 0; ks < 4; ++ks) { const bf16x8 bb = *(const LAS bf16x8*)(ST + l15 * STLD + 32 * ks + 8 * lq); acc = __builtin_amdgcn_mfma_f32_16x16x32_bf16(c1[ks], bb, acc, 0, 0, 0); }
            if (w < 4) { const f32x4 uu = (f32x4){bflo(cuw.x), bfhi(cuw.x), bflo(cuw.y), bfhi(cuw.y)}; const f32x4 wv = uu - acc;
                *(LAS u32x2*)(WT + l15 * WTLD + 16 * mt + 4 * lq) = (u32x2){cvt_pk_bf16(wv[0], wv[1]), cvt_pk_bf16(wv[2], wv[3])}; }
            asm volatile("s_waitcnt lgkmcnt(0)" ::: "memory"); __builtin_amdgcn_s_barrier(); asm volatile("" ::: "memory");
            bf16x8 wb[2];
#pragma unroll
            for (int ks = 0; ks < 2; ++ks) wb[ks] = *(const LAS bf16x8*)(WT + l15 * WTLD + 32 * ks + 8 * lq);
            if (w >= 4) {
#pragma unroll
                for (int ks = 0; ks < 2; ++ks) acc = __builtin_amdgcn_mfma_f32_16x16x32_bf16(c2[ks], wb[ks], acc, 0, 0, 0);
                float* o = GO + (size_t)(b * SEQ + n * 64 + 16 * mt + 4 * lq) * 512 + h * 128 + es * 16 + l15;
#pragma unroll
                for (int i = 0; i < 4; ++i) o[(size_t)i * 512] = acc[i];
            }
            { f32x4 sn = Sreg * cdec;
#pragma unroll
              for (int ks = 0; ks < 2; ++ks) sn = __builtin_amdgcn_mfma_f32_16x16x32_bf16(c3[ks], wb[ks], sn, 0, 0, 0);
              Sreg = sn; }
            *(LAS u32x2*)(ST + l15 * STLD + 16 * w + 4 * lq) = (u32x2){cvt_pk_bf16(Sreg[0], Sreg[1]), cvt_pk_bf16(Sreg[2], Sreg[3])};
            asm volatile("s_waitcnt lgkmcnt(0)" ::: "memory"); __builtin_amdgcn_s_barrier(); asm volatile("" ::: "memory");
        }
#undef GS_LOAD
    }
    __syncthreads();
}
DI void gdn_post(const Ctx& C, const float* GO, const bf16_t* Big, const float* out_g, bf16_t* Mix) {
    const f32x2 g = *(const f32x2*)(out_g + 2 * C.lane);
    for (int tok = C.gw; tok < M; tok += C.ngw) {
        f32x2 o[4];
#pragma unroll
        for (int h = 0; h < 4; ++h) o[h] = *(const f32x2*)(GO + (size_t)tok * 512 + h * 128 + 2 * C.lane);
        float ss[4];
#pragma unroll
        for (int h = 0; h < 4; ++h) ss[h] = wave_sum(o[h][0] * o[h][0] + o[h][1] * o[h][1]);
        unsigned outw[4];
#pragma unroll
        for (int h = 0; h < 4; ++h) { const float rstd = rsqrtf(ss[h] * (1.f / 128.f) + EPS);
            const unsigned gw_ = *(const unsigned*)(Big + (size_t)tok * ABPAD + 2048 + h * 128 + 2 * C.lane);
            outw[h] = cvt_pk_bf16(o[h][0] * rstd * g[0] * siluf_(bflo(gw_)), o[h][1] * rstd * g[1] * siluf_(bfhi(gw_))); }
        asm volatile("" ::: "memory");
#pragma unroll
        for (int h = 0; h < 4; ++h) *(unsigned*)(Mix + (size_t)tok * D + 512 + h * 128 + 2 * C.lane) = outw[h];
    }
}

#define MFMA32(a, b, c) __builtin_amdgcn_mfma_f32_32x32x16_bf16((a), (b), (c), 0, 0, 0)
DI bf16x8 mk8(unsigned a, unsigned b, unsigned c, unsigned d) { return __builtin_bit_cast(bf16x8, (u32x4){a, b, c, d}); }

DI void chunk_attn(const Ctx& C, const bf16_t* QKb  , const bf16_t* VT  , bf16_t* Mix, const float* qg, const float* kg, const float* relb  ) {
    constexpr int KLD = 72, VLD = 72;
    LAS bf16_t* Kt = (LAS bf16_t*)C.lds;
    LAS bf16_t* Vt = Kt + 4 * 64 * KLD;
    LAS float* bias = (LAS float*)(Vt + 4 * 64 * VLD);
    const int w = C.wave, r = C.lane & 31, hh = C.lane >> 5, hw = w >> 1, qb = w & 1;
    for (int u = blockIdx.x; u < BATCH * 32 * 4; u += gridDim.x) {
        int b, c, hg;
        if (gridDim.x == 256) { const int x = u & 7, k = (u >> 3) & 31, it = u >> 8, combo = x * 4 + it; b = combo >> 2; hg = combo & 3; c = (k + 8 * it) & 31; }
        else { b = u >> 7; c = (u >> 2) & 31; hg = u & 3; }
        const int head = hg * 4 + hw;
        __syncthreads();
        for (int i = C.tid; i < 4 * 257; i += NTHR) { const int h4 = i / 257, k = i - h4 * 257; bias[h4 * 260 + k] = relb[(hg * 4 + h4) * 257 + k] * 1.4426950408889634f; }
        const int qrow = b * SEQ + c * 64 + qb * 32 + r;
        bf16x8 qfr[4];
        { float qv[4][8]; float ss = 0.f;
#pragma unroll
          for (int s = 0; s < 4; ++s) { const u32x4 wq = *(const u32x4*)(QKb + (size_t)qrow * 2048 + head * 64 + 16 * s + 8 * hh); unpack8(wq, qv[s]);
#pragma unroll
              for (int j = 0; j < 8; ++j) ss += qv[s][j] * qv[s][j]; }
          ss += __shfl_xor(ss, 32); const float rstd = rsqrtf(ss * (1.f / 64.f) + EPS) * (0.125f * 1.4426950408889634f);
#pragma unroll
          for (int s = 0; s < 4; ++s) { const f32x4 g0 = *(const f32x4*)(qg + 16 * s + 8 * hh), g1 = *(const f32x4*)(qg + 16 * s + 8 * hh + 4);
              qfr[s] = mk8(cvt_pk_bf16(qv[s][0] * rstd * g0[0], qv[s][1] * rstd * g0[1]), cvt_pk_bf16(qv[s][2] * rstd * g0[2], qv[s][3] * rstd * g0[3]),
                           cvt_pk_bf16(qv[s][4] * rstd * g1[0], qv[s][5] * rstd * g1[1]), cvt_pk_bf16(qv[s][6] * rstd * g1[2], qv[s][7] * rstd * g1[3])); } }
        float mrun = -1e30f, lrun = 0.f; f32x16 O0, O1;
#pragma unroll
        for (int i = 0; i < 16; ++i) { O0[i] = 0.f; O1[i] = 0.f; }
        const int c0 = c > 8 ? c - 8 : 0; const int qpos = c * 64 + qb * 32 + r;
        u32x4 pk[4], pv[4];
#define CA_LOAD(kc_) do { _Pragma("unroll") for (int i = 0; i < 4; ++i) { const int pid = C.tid + NTHR * i; const int h4 = pid >> 9, row_ = (pid >> 3) & 63, pc = pid & 7; \
            pk[i] = *(const u32x4*)(QKb + (size_t)(b * SEQ + (kc_) * 64 + row_) * 2048 + 1024 + (hg * 4 + h4) * 64 + pc * 8); \
            pv[i] = *(const u32x4*)(VT + (size_t)((hg * 4 + h4) * 64 + row_) * M + b * SEQ + (kc_) * 64 + pc * 8); } } while (0)
        CA_LOAD(c0);
        for (int kc = c0; kc <= c; ++kc) {
            __syncthreads();
#pragma unroll
            for (int i = 0; i < 4; ++i) { const int pid = C.tid + NTHR * i; const int h4 = pid >> 9, row_ = (pid >> 3) & 63, pc = pid & 7;
                float kv[8]; unpack8(pk[i], kv);
                float ss = 0.f;
#pragma unroll
                for (int j = 0; j < 8; ++j) ss += kv[j] * kv[j];
                ss += __shfl_xor(ss, 1); ss += __shfl_xor(ss, 2); ss += __shfl_xor(ss, 4);
                const float rstd = rsqrtf(ss * (1.f / 64.f) + EPS); const f32x4 g0 = *(const f32x4*)(kg + pc * 8), g1 = *(const f32x4*)(kg + pc * 8 + 4);
                *(LAS u32x4*)(Kt + (h4 * 64 + row_) * KLD + pc * 8) = (u32x4){cvt_pk_bf16(kv[0] * rstd * g0[0], kv[1] * rstd * g0[1]), cvt_pk_bf16(kv[2] * rstd * g0[2], kv[3] * rstd * g0[3]),
                                                                              cvt_pk_bf16(kv[4] * rstd * g1[0], kv[5] * rstd * g1[1]), cvt_pk_bf16(kv[6] * rstd * g1[2], kv[7] * rstd * g1[3])};
                *(LAS u32x4*)(Vt + (h4 * 64 + row_) * VLD + pc * 8) = pv[i]; }
            __syncthreads();
            if (kc < c) CA_LOAD(kc + 1);
#pragma unroll
            for (int sub = 0; sub < 2; ++sub) {
                f32x16 acc;
#pragma unroll
                for (int i = 0; i < 16; ++i) acc[i] = 0.f;
#pragma unroll
                for (int s = 0; s < 4; ++s) { const bf16x8 a = *(const LAS bf16x8*)(Kt + (hw * 64 + sub * 32 + r) * KLD + 16 * s + 8 * hh); acc = MFMA32(a, qfr[s], acc); }
                float mt = -1e30f; const int kbase = kc * 64 + sub * 32;
                if (qpos - (kbase + 31) >= 128) {
                    const float bc = bias[hw * 260 + 256];
#pragma unroll
                    for (int i = 0; i < 16; ++i) { acc[i] += bc; mt = fmaxf(mt, acc[i]); }
                } else {
#pragma unroll
                    for (int i = 0; i < 16; ++i) { const int krow = (i & 3) + 8 * (i >> 2) + 4 * hh; int rel = qpos - (kbase + krow); rel = rel > 128 ? 128 : (rel < -128 ? -128 : rel);
                        acc[i] += bias[hw * 260 + rel + 128]; mt = fmaxf(mt, acc[i]); }
                }
                mt = fmaxf(mt, __shfl_xor(mt, 32));
                const float mnew = fmaxf(mrun, mt), alpha = __builtin_amdgcn_exp2f(mrun - mnew); float ls = 0.f;
#pragma unroll
                for (int i = 0; i < 16; ++i) { acc[i] = __builtin_amdgcn_exp2f(acc[i] - mnew); ls += acc[i]; }
                ls += __shfl_xor(ls, 32); lrun = lrun * alpha + ls; mrun = mnew;
                if (__builtin_amdgcn_ballot_w64(alpha != 1.f) != 0ull) {
#pragma unroll
                    for (int i = 0; i < 16; ++i) { O0[i] *= alpha; O1[i] *= alpha; } }
                const bf16x8 pa0 = mk8(cvt_pk_bf16(acc[0], acc[1]), cvt_pk_bf16(acc[2], acc[3]), cvt_pk_bf16(acc[4], acc[5]), cvt_pk_bf16(acc[6], acc[7]));
                const bf16x8 pa1 = mk8(cvt_pk_bf16(acc[8], acc[9]), cvt_pk_bf16(acc[10], acc[11]), cvt_pk_bf16(acc[12], acc[13]), cvt_pk_bf16(acc[14], acc[15]));
#pragma unroll
                for (int db = 0; db < 2; ++db) {
                    const LAS bf16_t* vrow = Vt + (hw * 64 + db * 32 + r) * VLD + sub * 32;
                    const u32x2 l0 = *(const LAS u32x2*)(vrow + 4 * hh), h0 = *(const LAS u32x2*)(vrow + 8 + 4 * hh), l1 = *(const LAS u32x2*)(vrow + 16 + 4 * hh), h1 = *(const LAS u32x2*)(vrow + 24 + 4 * hh);
                    if (db == 0) { O0 = MFMA32(mk8(l0.x, l0.y, h0.x, h0.y), pa0, O0); O0 = MFMA32(mk8(l1.x, l1.y, h1.x, h1.y), pa1, O0); }
                    else         { O1 = MFMA32(mk8(l0.x, l0.y, h0.x, h0.y), pa0, O1); O1 = MFMA32(mk8(l1.x, l1.y, h1.x, h1.y), pa1, O1); }
                }
            }
        }
#undef CA_LOAD
        const float inv = 1.f / lrun;
        bf16_t* orow = Mix + (size_t)qrow * D + head * 64;
#pragma unroll
        for (int q4 = 0; q4 < 4; ++q4) {
            *(u32x2*)(orow + 8 * q4 + 4 * hh)      = (u32x2){cvt_pk_bf16(O0[4 * q4] * inv, O0[4 * q4 + 1] * inv), cvt_pk_bf16(O0[4 * q4 + 2] * inv, O0[4 * q4 + 3] * inv)};
            *(u32x2*)(orow + 32 + 8 * q4 + 4 * hh) = (u32x2){cvt_pk_bf16(O1[4 * q4] * inv, O1[4 * q4 + 1] * inv), cvt_pk_bf16(O1[4 * q4 + 2] * inv, O1[4 * q4 + 3] * inv)};
        }
    }
    __syncthreads();
}

DI void cross_attn(const Ctx& C, const bf16_t* QX  , const bf16_t* KALL  , const bf16_t* VTALL  , bf16_t* Mix, const float* qg  , int layer) {
    constexpr int KLD = 264, VLD = 40;
    LAS bf16_t* Kt = (LAS bf16_t*)C.lds;
    LAS bf16_t* Vt = Kt + 32 * KLD;
    LAS bf16x8* Qs = (LAS bf16x8*)(Vt + 256 * VLD);
    const int w = C.wave, r = C.lane & 31, hh = C.lane >> 5, qs = w >> 1, dh = w & 1;
    for (int u = blockIdx.x; u < BATCH * 4 * 16; u += gridDim.x) {
        int b, head, qg16;
        if (gridDim.x == 256) { const int x = u & 7, k = (u >> 3) & 31, it = u >> 8, combo = x * 4 + it * 2 + (k >> 4); b = combo >> 2; head = combo & 3; qg16 = k & 15; }
        else { b = u >> 6; head = (u >> 4) & 3; qg16 = u & 15; }
        const int qrow = b * SEQ + qg16 * 128 + qs * 32 + r;
        __syncthreads();
        { float ss = 0.f; const bf16_t* qp = QX + (size_t)qrow * D + head * 256 + 8 * hh;
#pragma unroll
          for (int s = 0; s < 16; ++s) { const u32x4 w4 = *(const u32x4*)(qp + 16 * s); float qv[8]; unpack8(w4, qv);
#pragma unroll
              for (int j = 0; j < 8; ++j) ss += qv[j] * qv[j]; }
          ss += __shfl_xor(ss, 32); const float rstd = rsqrtf(ss * (1.f / 256.f) + EPS) * (0.0625f * 1.4426950408889634f);
#pragma unroll
          for (int s = 0; s < 16; ++s) { const u32x4 w4 = *(const u32x4*)(qp + 16 * s); float qv[8]; unpack8(w4, qv); const f32x4 g0 = *(const f32x4*)(qg + 16 * s + 8 * hh), g1 = *(const f32x4*)(qg + 16 * s + 8 * hh + 4);
              const bf16x8 fr = mk8(cvt_pk_bf16(qv[0] * rstd * g0[0], qv[1] * rstd * g0[1]), cvt_pk_bf16(qv[2] * rstd * g0[2], qv[3] * rstd * g0[3]),
                           cvt_pk_bf16(qv[4] * rstd * g1[0], qv[5] * rstd * g1[1]), cvt_pk_bf16(qv[6] * rstd * g1[2], qv[7] * rstd * g1[3]));
              if (dh == 0) Qs[(qs * 16 + s) * 64 + C.lane] = fr; } }
        float mrun = -1e30f, lrun = 0.f; f32x16 O[4];
#pragma unroll
        for (int db = 0; db < 4; ++db)
#pragma unroll
            for (int i = 0; i < 16; ++i) O[db][i] = 0.f;
        u32x4 pk[2], pv[2];
#define XA_LOAD(kt_) do { _Pragma("unroll") for (int i = 0; i < 2; ++i) { const int pid = C.tid + NTHR * i; \
            { const int key = pid >> 5, pc = pid & 31; pk[i] = *(const u32x4*)(KALL + (size_t)(b * NMEM + (kt_) * 32 + key) * 4096 + layer * 1024 + head * 256 + pc * 8); } \
            { const int d = pid >> 2, pc = pid & 3; pv[i] = *(const u32x4*)(VTALL + (size_t)(layer * 1024 + head * 256 + d) * MMEM + b * NMEM + (kt_) * 32 + pc * 8); } } } while (0)
        XA_LOAD(0);
        for (int kt = 0; kt < 8; ++kt) {
            __syncthreads();
#pragma unroll
            for (int i = 0; i < 2; ++i) { const int pid = C.tid + NTHR * i; { const int key = pid >> 5, pc = pid & 31; *(LAS u32x4*)(Kt + key * KLD + pc * 8) = pk[i]; }
                { const int d = pid >> 2, pc = pid & 3; *(LAS u32x4*)(Vt + d * VLD + pc * 8) = pv[i]; } }
            __syncthreads();
            if (kt < 7) XA_LOAD(kt + 1);
            f32x16 acc;
#pragma unroll
            for (int i = 0; i < 16; ++i) acc[i] = 0.f;
#pragma unroll
            for (int s = 0; s < 16; ++s) { const bf16x8 a = *(const LAS bf16x8*)(Kt + r * KLD + 16 * s + 8 * hh); acc = MFMA32(a, Qs[(qs * 16 + s) * 64 + C.lane], acc); }
            float mt = -1e30f;
#pragma unroll
            for (int i = 0; i < 16; ++i) mt = fmaxf(mt, acc[i]);
            mt = fmaxf(mt, __shfl_xor(mt, 32));
            const float mnew = fmaxf(mrun, mt), alpha = __builtin_amdgcn_exp2f(mrun - mnew); float ls = 0.f;
#pragma unroll
            for (int i = 0; i < 16; ++i) { acc[i] = __builtin_amdgcn_exp2f(acc[i] - mnew); ls += acc[i]; }
            const bool resc = __builtin_amdgcn_ballot_w64(alpha != 1.f) != 0ull;
            ls += __shfl_xor(ls, 32); lrun = lrun * alpha + ls; mrun = mnew;
            const bf16x8 pa0 = mk8(cvt_pk_bf16(acc[0], acc[1]), cvt_pk_bf16(acc[2], acc[3]), cvt_pk_bf16(acc[4], acc[5]), cvt_pk_bf16(acc[6], acc[7]));
            const bf16x8 pa1 = mk8(cvt_pk_bf16(acc[8], acc[9]), cvt_pk_bf16(acc[10], acc[11]), cvt_pk_bf16(acc[12], acc[13]), cvt_pk_bf16(acc[14], acc[15]));
#pragma unroll
            for (int db = 0; db < 4; ++db) {
                if (resc) {
#pragma unroll
                    for (int i = 0; i < 16; ++i) O[db][i] *= alpha; }
                const LAS bf16_t* vrow = Vt + (dh * 128 + db * 32 + r) * VLD;
                const u32x2 l0 = *(const LAS u32x2*)(vrow + 4 * hh), h0 = *(const LAS u32x2*)(vrow + 8 + 4 * hh), l1 = *(const LAS u32x2*)(vrow + 16 + 4 * hh), h1 = *(const LAS u32x2*)(vrow + 24 + 4 * hh);
                O[db] = MFMA32(mk8(l0.x, l0.y, h0.x, h0.y), pa0, O[db]); O[db] = MFMA32(mk8(l1.x, l1.y, h1.x, h1.y), pa1, O[db]);
            }
        }
        const float inv = 1.f / lrun;
        bf16_t* orow = Mix + (size_t)qrow * D + head * 256 + dh * 128;
#pragma unroll
        for (int db = 0; db < 4; ++db)
#pragma unroll
            for (int q4 = 0; q4 < 4; ++q4)
                *(u32x2*)(orow + db * 32 + 8 * q4 + 4 * hh) = (u32x2){cvt_pk_bf16(O[db][4 * q4] * inv, O[db][4 * q4 + 1] * inv), cvt_pk_bf16(O[db][4 * q4 + 2] * inv, O[db][4 * q4 + 3] * inv)};
    }
    __syncthreads();
}

#define XB_TMO      128
#define XB_XCNT(j)  (256  + 64 * (j))
#define XB_XSUB(j)  (1280 + 64 * (j))
#define XB_XGEN(j)  (2304 + 64 * (j))
#define XB_TOP      3328
#define XB_TOPGEN   3392
#define XB_SPIN_CAP (1u << 22)
DI unsigned xb_ld(unsigned* p)              { return __hip_atomic_load(p, __ATOMIC_RELAXED, __HIP_MEMORY_SCOPE_AGENT); }
DI unsigned xb_add(unsigned* p, unsigned v) { return __hip_atomic_fetch_add(p, v, __ATOMIC_RELAXED, __HIP_MEMORY_SCOPE_AGENT); }
DI unsigned xb_xcc_id() { return (unsigned)__builtin_amdgcn_s_getreg((3 << 11) | 20) & 0xFu; }
#define XB_SPIN(cond, bar) do { unsigned _sp = 0; while (cond) { __builtin_amdgcn_s_sleep(1); \
    if ((++_sp & 255u) == 0u) { if (xb_ld(&(bar)[XB_TMO])) break; if (_sp > XB_SPIN_CAP) { atomicAdd(&(bar)[XB_TMO], 1u); break; } } } } while (0)
struct XcdBarrier { unsigned* bar; unsigned x; volatile LAS unsigned* st; };
DI XcdBarrier xcd_barrier_post(unsigned* bar, volatile LAS unsigned* st) {
    XcdBarrier b; b.bar = bar; b.x = xb_xcc_id(); b.st = st;
    if (threadIdx.x == 0) (void)xb_add(&bar[XB_XCNT(b.x)], 1u);
    return b;
}
DI void xcd_barrier_complete(unsigned* bar, unsigned x, unsigned& nloc, unsigned& nx) {
    const unsigned G = gridDim.x * gridDim.y * gridDim.z;
    unsigned sum, cnt, mine, sp = 0u;
    for (;;) {
        sum = 0u; cnt = 0u; mine = 0u;
#pragma unroll
        for (unsigned j = 0; j < 16; ++j) { const unsigned c = xb_ld(&bar[XB_XCNT(j)]); sum += c; cnt += (c > 0u) ? 1u : 0u; mine = (j == x) ? c : mine; }
        if (sum == G) break;
        __builtin_amdgcn_s_sleep(1);
        if ((++sp & 255u) == 0u) { if (xb_ld(&bar[XB_TMO])) break; if (sp > XB_SPIN_CAP) { atomicAdd(&bar[XB_TMO], 1u); break; } }
    }
    nloc = mine > 0u ? mine : 1u; nx = cnt > 0u ? cnt : 1u;
}
DI void xcd_barrier(const XcdBarrier& b) {
    asm volatile("s_waitcnt vmcnt(0)" ::: "memory");
    __syncthreads();
    if (threadIdx.x == 0) {
        unsigned* bar = b.bar;
        __builtin_amdgcn_s_waitcnt(0);
        unsigned nloc = b.st[0], nx = b.st[1];
        if (nloc == 0u) { xcd_barrier_complete(bar, b.x, nloc, nx); b.st[0] = nloc; b.st[1] = nx; }
        const unsigned old = xb_add(&bar[XB_XSUB(b.x)], 1u);
        const unsigned gen = old / nloc;
        if (old + 1u == (gen + 1u) * nloc) {
            __builtin_amdgcn_fence(__ATOMIC_RELEASE, "agent");
            asm volatile("s_waitcnt vmcnt(0)" ::: "memory");
            const unsigned og = xb_add(&bar[XB_TOP], 1u);
            const unsigned tg = og / nx;
            if (og + 1u == (tg + 1u) * nx) xb_add(&bar[XB_TOPGEN], 1u);
            else XB_SPIN(xb_ld(&bar[XB_TOPGEN]) == tg, bar);
            __builtin_amdgcn_fence(__ATOMIC_ACQUIRE, "agent");
            xb_add(&bar[XB_XGEN(b.x)], 1u);
            asm volatile("s_waitcnt vmcnt(0)" ::: "memory");
        } else {
            XB_SPIN(xb_ld(&bar[XB_XGEN(b.x)]) == gen, bar);
            __builtin_amdgcn_fence(__ATOMIC_ACQUIRE, "agent");
            asm volatile("s_waitcnt vmcnt(0)" ::: "memory");
        }
    }
    __syncthreads();
}
struct Args { const float* in[36]; float* out; unsigned char* wsp; int ph_lo, ph_hi; };
constexpr int NPHASES = 43;

#define CV_JOB(W_, K_, N_, ldw_, noff_, WT_, rowoff_, grp_, gstride_, gain_) { const int items_ = ((K_) / 64) * (((N_) + 31) / 32); \
        if (r < items_) { tr_item((W_), (K_), (N_), (ldw_), (noff_), (WT_), (rowoff_), (grp_), (gstride_), scr_, r, C.lane, (gain_)); continue; } r -= items_; }
DI void convert_layer(const Ctx& C, const Args& a, int layer) {
    unsigned char* wl_ = a.wsp + WS_WL; const int i = layer >> 1;
    LAS float* scr_ = (LAS float*)(C.lds + C.wave * 16384);
    constexpr int NO = 1 << 20;
    if ((layer & 1) == 0) {
        constexpr int TOT = 16 * 81 + 16 * 32 + 8 * 16 + 2 * 16 * 32 + 2 * 16 * 88 + 44 * 32;
        for (int it = C.gw; it < TOT; it += C.ngw) { int r = it;
            CV_JOB(a.in[3] + (size_t)i * D * ABIN, D, ABIN, ABIN, 0, (bf16_t*)(wl_ + WL_IN), 0, NO, 0, a.in[2] + i * D)
            CV_JOB(a.in[4] + (size_t)i * D * D, D, D, D, 0, (bf16_t*)(wl_ + WL_OUT), 0, NO, 0, nullptr)
            CV_JOB(a.in[13] + (size_t)i * 512 * 512, 512, 512, 512, 0, (bf16_t*)(wl_ + WL_GLU), 0, NO, 0, nullptr)
            CV_JOB(a.in[27] + (size_t)layer * D * D, D, D, D, 0, (bf16_t*)(wl_ + WL_XQ), 0, NO, 0, a.in[26] + layer * D)
            CV_JOB(a.in[29] + (size_t)layer * D * D, D, D, D, 0, (bf16_t*)(wl_ + WL_XO), 0, NO, 0, nullptr)
            CV_JOB(a.in[33] + (size_t)layer * D * FF, D, FF, FF, 0, (bf16_t*)(wl_ + WL_GU), 0, 128, 256, a.in[32] + layer * D)
            CV_JOB(a.in[34] + (size_t)layer * D * FF, D, FF, FF, 0, (bf16_t*)(wl_ + WL_GU), 128, 128, 256, a.in[32] + layer * D)
            CV_JOB(a.in[35] + (size_t)layer * FF * D, FF, D, D, 0, (bf16_t*)(wl_ + WL_DN), 0, NO, 0, nullptr)
        }
        s5_build(C, a.in[5] + i * 2048, a.in[6] + i * 2048, a.in[7] + i * 32, a.in[8] + (size_t)i * 32768, a.in[9] + (size_t)i * 32768, a.in[10] + (size_t)i * 32768, a.in[11] + (size_t)i * 32768,
                 (bf16_t*)(a.wsp + WS_SCR + SC_T), (bf16_t*)(a.wsp + WS_SCR + SC_BM));
    } else {
        constexpr int TOT = 16 * 64 + 16 * 32 + 16 * 32 + 2 * 16 * 32 + 2 * 16 * 88 + 44 * 32;
        for (int it = C.gw; it < TOT; it += C.ngw) { int r = it;
            CV_JOB(a.in[20] + (size_t)i * D * 3 * D, D, 2 * D, 3 * D, 0, (bf16_t*)(wl_ + WL_IN), 0, NO, 0, a.in[19] + i * D)
            CV_JOB(a.in[20] + (size_t)i * D * 3 * D, D, D, 3 * D, 2 * D, (bf16_t*)(wl_ + WL_V), 0, NO, 0, a.in[19] + i * D)
            CV_JOB(a.in[21] + (size_t)i * D * D, D, D, D, 0, (bf16_t*)(wl_ + WL_OUT), 0, NO, 0, nullptr)
            CV_JOB(a.in[27] + (size_t)layer * D * D, D, D, D, 0, (bf16_t*)(wl_ + WL_XQ), 0, NO, 0, a.in[26] + layer * D)
            CV_JOB(a.in[29] + (size_t)layer * D * D, D, D, D, 0, (bf16_t*)(wl_ + WL_XO), 0, NO, 0, nullptr)
            CV_JOB(a.in[33] + (size_t)layer * D * FF, D, FF, FF, 0, (bf16_t*)(wl_ + WL_GU), 0, 128, 256, a.in[32] + layer * D)
            CV_JOB(a.in[34] + (size_t)layer * D * FF, D, FF, FF, 0, (bf16_t*)(wl_ + WL_GU), 128, 128, 256, a.in[32] + layer * D)
            CV_JOB(a.in[35] + (size_t)layer * FF * D, FF, D, D, 0, (bf16_t*)(wl_ + WL_DN), 0, NO, 0, nullptr)
        }
    }
}

__global__ void __launch_bounds__(NTHR, 2) fwd_kernel(Args a) {
    extern __shared__ __attribute__((aligned(16))) unsigned char lds_raw[];
    LAS unsigned char* lds = (LAS unsigned char*)lds_raw;
#define ws     ws_
#define wl     (ws_ + WS_WL)
#define scr    (ws_ + WS_SCR)
#define PSJ(j) ((float*)(ws_ + WS_PS + (size_t)((j) & 1) * MiB))
#define SSC    ((float*)(ws_ + WS_SS))
#define OUTF   xo_
#define XB     ((bf16_t*)(ws_ + WS_MIX))
#define MIX    ((bf16_t*)xo_)
#define HN     ((bf16_t*)((unsigned char*)xo_ + 32 * MiB))
#define BIG    ((bf16_t*)(ws_ + WS_BIG))
#define LOGITS ((float*)(ws_ + WS_LOG))
#define KALL   ((bf16_t*)(ws_ + WS_KALL))
#define VTALL  ((bf16_t*)(ws_ + WS_VTALL))
#define MEMN   ((bf16_t*)(ws_ + WS_MEMN))
    volatile LAS unsigned* MISC = (volatile LAS unsigned*)(lds + LDS_BYTES - 64);
    if (threadIdx.x < 16) MISC[threadIdx.x] = 0u;
    __syncthreads();
    XcdBarrier xbar; xbar.bar = (unsigned*)a.wsp; xbar.x = 0; xbar.st = nullptr;
    if (a.ph_hi - a.ph_lo > 1) xbar = xcd_barrier_post((unsigned*)a.wsp, MISC);
    const int lo = a.ph_lo, hi = a.ph_hi; int ph = 0;
#define PH_BEGIN if (ph >= lo && ph < hi) { const Ctx C = make_ctx(lds); unsigned char* ws_ = a.wsp; float* xo_ = a.out; int G = gridDim.x, bx = blockIdx.x; \
        asm volatile("" : "+s"(ws_), "+s"(xo_), "+s"(G), "+s"(bx));
#define PH_END   if (ph + 1 < hi) { if (ph == lo) cg::this_grid().sync(); else { xcd_barrier(xbar); if (DBG_DOUBLE & 512) xcd_barrier(xbar); } } } ++ph;
    using namespace pg8;
    PH_BEGIN
        { LAS float* scr_ = (LAS float*)(C.lds + C.wave * 16384);
          for (int it = C.gw; it < 8 * 512; it += C.ngw) { const int job = it >> 9, l = job & 3, isv = job >> 2;
              tr_item(a.in[28] + (size_t)l * D * 2 * D, D, D, 2 * D, isv * D, (bf16_t*)(scr + SC_WKV + (size_t)isv * 8 * MiB), l * 1024, 1 << 20, 0, scr_, it & 511, C.lane); } }
        convert_layer(C, a, 0);
        if (DBG_DOUBLE & 256) convert_layer(C, a, 0);
        rms_rows(C, a.in[1], a.in[25], MEMN, MMEM);
        x_prep(C, a.in[0], XB, PSJ(0));
    PH_END
    PH_BEGIN
        const int half = G / 2; const bool second = bx >= half;
        if (!second) { Gemm g{MEMN, (const bf16_t*)(scr + SC_WKV), D, D, D, 0, 0}; Order S{MMEM / 256, 4096 / 256, 1, half, bx}; EpiStore E{KALL, 4096, 0, nullptr, nullptr}; gemm_phase<EpiStore, true>(lds, g, S, E); }
        else         { Gemm g{(const bf16_t*)(scr + SC_WKV + 8 * MiB), MEMN, D, D, D, 0, 0}; Order S{4096 / 256, MMEM / 256, 1, G - half, bx - half}; EpiStore E{VTALL, MMEM, 0, nullptr, nullptr}; gemm_phase<EpiStore, true>(lds, g, S, E); }
    PH_END
    for (int layer = 0; layer < 4; ++layer) {
        const int i = layer >> 1, sj = layer * 3;
        if ((layer & 1) == 0) {
            PH_BEGIN
                if (layer == 0) knorm_phase(C, KALL, a.in[31]);
                Gemm g{XB, (const bf16_t*)(wl + WL_IN), D, D, D, 0, 0}; Order S{M / 256, ABPAD / 256, 1, G, bx}; EpiInProj E{(bf16_t*)(scr + SC_UG), BIG, LOGITS, PSJ(sj)}; gemm_phase<EpiInProj, true>(lds, g, S, E);
            PH_END
            PH_BEGIN
                if (bx < 64) { Gemm g{(const bf16_t*)(scr + SC_UG), (const bf16_t*)(scr + SC_BM), S5K, 512, 512, (long)S5ROWS * S5K, 256L * 512}; Order S{2, 1, 32, 64, bx}; EpiS5State E{(float*)(scr + SC_S)}; gemm_phase<EpiS5State, true>(lds, g, S, E); }
                gdn_pre(C, BIG, LOGITS, a.in[15] + (size_t)i * 4 * 1536, a.in[16] + i * 4, a.in[17] + i * 4, scr, (unsigned char*)HN);
                if (DBG_DOUBLE & 4) gdn_pre(C, BIG, LOGITS, a.in[15] + (size_t)i * 4 * 1536, a.in[16] + i * 4, a.in[17] + i * 4, scr, (unsigned char*)HN);
            PH_END
            PH_BEGIN
                s5_scan(C, a.in[5] + i * 2048, a.in[6] + i * 2048, a.in[7] + i * 32, (const float*)(scr + SC_S), (bf16_t*)(scr + SC_UG));
                gdn_seq(C, scr, (const unsigned char*)HN, (float*)MIX);
            PH_END
            PH_BEGIN
                const int half = G / 2;
                if (bx < half) { Gemm g{(const bf16_t*)(scr + SC_UG), (const bf16_t*)(scr + SC_T), S5K, S5K, S5K, (long)S5ROWS * S5K, 512L * S5K}; Order S{2, 2, 32, half, bx}; EpiS5Y E{(const bf16_t*)(scr + SC_UG), a.in[12] + i * 512, BIG}; gemm_phase<EpiS5Y, true>(lds, g, S, E); }
                else { Ctx C2 = C; C2.gw = (bx - half) * NWAVES + C.wave; C2.ngw = (G - half) * NWAVES; gdn_post(C2, (const float*)MIX, BIG, a.in[18] + i * 128, MIX); }
            PH_END
            PH_BEGIN
                Gemm g{BIG, (const bf16_t*)(wl + WL_GLU), ABPAD, 512, 512, 0, 0}; Order S{M / 256, 2, 1, G, bx}; EpiGlu E{BIG, a.in[14] + i * 512, MIX}; gemm_phase<EpiGlu, true>(lds, g, S, E);
            PH_END
            PH_BEGIN
                Gemm g{MIX, (const bf16_t*)(wl + WL_OUT), D, D, D, 0, 0}; Order S{M / 256, 4, 1, G, bx}; EpiResid E{XB, nullptr, PSJ(sj + 1), (LAS float*)(lds + 131072)}; gemm_phase<EpiResid, true>(lds, g, S, E);
            PH_END
        } else {
            PH_BEGIN
                { Gemm g{XB, (const bf16_t*)(wl + WL_IN), D, D, D, 0, 0}; Order S{M / 256, 8, 1, G, bx}; EpiStore E{BIG, 2048, 0, PSJ(sj), nullptr}; gemm_phase<EpiStore, true>(lds, g, S, E); }
                { Gemm g{(const bf16_t*)(wl + WL_V), XB, D, D, D, 0, 0}; Order S{4, M / 256, 1, G, bx}; EpiStore E{BIG + (size_t)M * 2048, M, 0, nullptr, SSC}; gemm_phase<EpiStore, true>(lds, g, S, E); }
            PH_END
            PH_BEGIN
                chunk_attn(C, BIG, BIG + (size_t)M * 2048, MIX, a.in[22] + i * 64, a.in[23] + i * 64, a.in[24] + (size_t)i * 16 * 257);
                if (DBG_DOUBLE & 2) { chunk_attn(C, BIG, BIG + (size_t)M * 2048, MIX, a.in[22] + i * 64, a.in[23] + i * 64, a.in[24] + (size_t)i * 16 * 257); }
            PH_END
            PH_BEGIN
                { Gemm g{MIX, (const bf16_t*)(wl + WL_OUT), D, D, D, 0, 0}; Order S{M / 256, 4, 1, G, bx}; EpiResid E{XB, nullptr, PSJ(sj + 1), (LAS float*)(lds + 131072)}; gemm_phase<EpiResid, true>(lds, g, S, E); }
            PH_END
        }
        PH_BEGIN
            Gemm g{XB, (const bf16_t*)(wl + WL_XQ), D, D, D, 0, 0}; Order S{M / 256, 4, 1, G, bx}; EpiStore E{BIG, D, 0, PSJ(sj + 1), nullptr}; gemm_phase<EpiStore, true>(lds, g, S, E);
        PH_END
        PH_BEGIN
            cross_attn(C, BIG, KALL, VTALL, MIX, a.in[30] + layer * 256, layer);
                if (DBG_DOUBLE & 1) { cross_attn(C, BIG, KALL, VTALL, MIX, a.in[30] + layer * 256, layer); }
        PH_END
        PH_BEGIN
            { Gemm g{MIX, (const bf16_t*)(wl + WL_XO), D, D, D, 0, 0}; Order S{M / 256, 4, 1, G, bx}; EpiResid E{XB, nullptr, PSJ(sj + 2), (LAS float*)(lds + 131072)}; gemm_phase<EpiResid, true>(lds, g, S, E); }
        PH_END
        PH_BEGIN
            Gemm g{XB, (const bf16_t*)(wl + WL_GU), D, D, D, 0, 0}; Order S{M / 256, 2 * FF / 256, 1, G, bx}; EpiSwiglu E{BIG, PSJ(sj + 2)}; gemm_phase<EpiSwiglu, true>(lds, g, S, E);
        PH_END
        PH_BEGIN
            { Gemm g{BIG, (const bf16_t*)(wl + WL_DN), FF, FF, FF, 0, 0}; Order S{M / 256, 4, 1, G, bx}; EpiResid E{XB, layer == 3 ? OUTF : (float*)nullptr, layer < 3 ? PSJ(sj + 3) : (float*)nullptr, (LAS float*)(lds + 131072)}; gemm_phase<EpiResid, true>(lds, g, S, E); }
        PH_END
        if (layer < 3) {
            PH_BEGIN
                convert_layer(C, a, layer + 1);
                if (DBG_DOUBLE & 256) convert_layer(C, a, layer + 1);
if (((layer + 1) & 1) != 0) { const float* ps = PSJ(sj + 3); float* sc = SSC;
                    for (int r = C.gw * 64 + C.lane; r < M; r += C.ngw * 64) { const f32x4 a4 = *(const f32x4*)(ps + (size_t)r * 4); sc[r] = (a4[0] + a4[1]) + (a4[2] + a4[3]); } }
            PH_END
        }
    }
#if DBG_CHECK
    if (hi == NPHASES) { cg::this_grid().sync(); if (bx == 0 && threadIdx.x == 0) { const unsigned f = *(volatile unsigned*)ws; if (f != 0x7f7f7f7fu) X[0] = 10000.f * (float)f; } }
#endif
}

extern "C" void kernel_launch(void* const* d_in, const int* in_sizes, int n_in, void* d_out, int out_size, void* d_ws, size_t ws_size, hipStream_t stream) {
    static int grid = 0;
    if (grid == 0) {
        if (n_in != 36 || out_size != M * D || ws_size < WS_END) { fprintf(stderr, "kernel_launch: unexpected problem (n_in %d, out %d, ws %zu)\n", n_in, out_size, ws_size); grid = -1; return; }
        int dev = 0, cus = 0;
        hipGetDevice(&dev); hipDeviceGetAttribute(&cus, hipDeviceAttributeMultiprocessorCount, dev);
        if (hipFuncSetAttribute((const void*)fwd_kernel, hipFuncAttributeMaxDynamicSharedMemorySize, LDS_BYTES) != hipSuccess) { fprintf(stderr, "kernel_launch: hipFuncSetAttribute failed\n"); grid = -1; return; }
        int per_cu = 0;
        if (hipOccupancyMaxActiveBlocksPerMultiprocessor(&per_cu, (const void*)fwd_kernel, NTHR, LDS_BYTES) != hipSuccess || per_cu < 1) { fprintf(stderr, "kernel_launch: occupancy query says %d\n", per_cu); per_cu = 1; }
        (void)hipGetLastError();
        grid = cus > 0 ? cus : 256;
    }
    if (grid < 0) return;
#if DBG_CHECK
    (void)hipMemsetAsync(d_ws, 0x7f, 4, stream);
#endif
    (void)hipMemsetAsync(d_ws, 0, 16384, stream);
    Args a{};
    for (int i = 0; i < 36; ++i) a.in[i] = (const float*)d_in[i];
    a.out = (float*)d_out; a.wsp = (unsigned char*)d_ws;
#if MK_ONE_LAUNCH
    a.ph_lo = 0; a.ph_hi = NPHASES;
    void* args[] = {&a};
    hipError_t e = hipLaunchCooperativeKernel((const void*)fwd_kernel, dim3(grid), dim3(NTHR), args, LDS_BYTES, stream);
    if (e != hipSuccess) fprintf(stderr, "cooperative launch failed: %s (grid %d)\n", hipGetErrorString(e), grid);
#else
    for (int p = 0; p < NPHASES; ++p) {
        a.ph_lo = p; a.ph_hi = p + 1;
        hipLaunchKernelGGL(fwd_kernel, dim3(grid), dim3(NTHR), LDS_BYTES, stream, a);
    }
#endif
}
```

```cpp
#include <hip/hip_runtime.h>
#include <hip/hip_cooperative_groups.h>
#include <cstdio>
#include <cstdint>
namespace cg = cooperative_groups;

#define DBG_NAIVE 0
#define DBG_NAIVE_GEMM 0
#define DBG_CHECK 0
#define DBG_SKIP 0
#define DBG_DOUBLE 0
#define DBG_A 1.0f
#define DBG_HALF 0
#ifndef MK_ONE_LAUNCH
#define MK_ONE_LAUNCH 1
#endif

#define LAS __attribute__((address_space(3)))
#define DI __device__ __forceinline__
typedef unsigned short bf16_t;
typedef short bf16x8 __attribute__((ext_vector_type(8)));
typedef float f32x4 __attribute__((ext_vector_type(4)));
typedef float f32x2 __attribute__((ext_vector_type(2)));
typedef float f32x16 __attribute__((ext_vector_type(16)));
typedef unsigned u32x4 __attribute__((ext_vector_type(4)));
typedef unsigned u32x2 __attribute__((ext_vector_type(2)));

constexpr int D = 1024, BATCH = 8, SEQ = 2048, M = BATCH * SEQ, NMEM = 256, MMEM = BATCH * NMEM;
constexpr int ABIN = 2568, ABPAD = 2816, FF = 2816;
constexpr float EPS = 1e-6f;
constexpr int S5L = 32, S5NCH = SEQ / S5L, S5ROWS = BATCH * S5NCH  , S5K = 640;
constexpr int NTHR = 512, NWAVES = 8;
constexpr int LDS_BYTES = 147456;

constexpr size_t MiB = 1u << 20;
constexpr size_t WS_SS = 65536;
constexpr size_t WS_PS = 31 * MiB;
constexpr size_t WS_WL = 1 * MiB;
constexpr size_t WL_IN = 0, WL_OUT = 6 * MiB, WL_GLU = 8 * MiB, WL_XQ = 9 * MiB, WL_XO = 11 * MiB, WL_GU = 13 * MiB, WL_DN = 24 * MiB;
constexpr size_t WL_V = 4 * MiB;
constexpr size_t WS_KALL = 33 * MiB, WS_VTALL = 49 * MiB, WS_MEMN = 65 * MiB, WS_HN = 69 * MiB, WS_MIX = 101 * MiB, WS_BIG = 133 * MiB, WS_LOG = 229 * MiB, WS_SCR = 230 * MiB, WS_END = 330 * MiB;
constexpr size_t SC_UG = 0, SC_T = 20 * MiB, SC_BM = 40 * MiB, SC_S = 48 * MiB;
constexpr size_t SC_WKV = 64 * MiB;
constexpr size_t SC_UT = 56 * MiB, SC_QG = 72 * MiB, SC_QK = 88 * MiB, SC_DEC = 96 * MiB;
constexpr size_t HN_WK = 0, HN_KT = 16 * MiB;

typedef __bf16 bf16x2_t __attribute__((ext_vector_type(2)));
DI unsigned cvt_pk_bf16(float lo, float hi) { const f32x2 v = {lo, hi}; const bf16x2_t b = __builtin_convertvector(v, bf16x2_t); return __builtin_bit_cast(unsigned, b); }
DI float bf2f(unsigned short b) { return __builtin_bit_cast(float, (unsigned)b << 16); }
DI float bflo(unsigned w) { return __builtin_bit_cast(float, w << 16); }
DI float bfhi(unsigned w) { return __builtin_bit_cast(float, w & 0xffff0000u); }
DI unsigned short f2bf(float f) { return (unsigned short)(cvt_pk_bf16(f, 0.f) & 0xffffu); }
DI float wave_sum(float v) {
#pragma unroll
    for (int o = 1; o < 64; o <<= 1) v += __shfl_xor(v, o);
    return v;
}
DI float sigmoidf_(float x) { return 1.f / (1.f + __expf(-x)); }
DI float siluf_(float x) { return x / (1.f + __expf(-x)); }
DI float gelu_tanh(float x) { const float z = 0.7978845608028654f * (x + 0.044715f * x * x * x); return x / (1.f + __expf(-2.f * z)); }
DI u32x4 pack8(const f32x4 a, const f32x4 b) { u32x4 w; w.x = cvt_pk_bf16(a[0], a[1]); w.y = cvt_pk_bf16(a[2], a[3]); w.z = cvt_pk_bf16(b[0], b[1]); w.w = cvt_pk_bf16(b[2], b[3]); return w; }
DI void unpack8(const u32x4 w, float* o) { o[0] = bflo(w.x); o[1] = bfhi(w.x); o[2] = bflo(w.y); o[3] = bfhi(w.y); o[4] = bflo(w.z); o[5] = bfhi(w.z); o[6] = bflo(w.w); o[7] = bfhi(w.w); }

DI float rstd_of(const float* ps, int row) {
    const f32x4 a = *(const f32x4*)(ps + (size_t)row * 4);
    return rsqrtf(((a[0] + a[1]) + (a[2] + a[3])) * (1.f / D) + EPS);
}
namespace pg8 {
constexpr int BM = 256, BK = 64, HALF = 128, HTB = HALF * BK * 2;
DI int lds_byte(int r, int c) { const int st = (r >> 4) * 2 + (c >> 5), rr = r & 15, cc = c & 31, ob = rr * 64 + cc * 2; return st * 1024 + (ob ^ (((ob >> 9) & 1) << 5)); }
DI void stage_rc(int b, int& R, int& C) { const int st = b / 1024, sb = b % 1024, swz = sb ^ (((sb >> 9) & 1) << 5); R = (st >> 1) * 16 + swz / 64; C = (st & 1) * 32 + (swz % 64) / 2; }
DI int perm32(int rho) { const int n = rho >> 4, i = rho & 15; return 8 * (i >> 2) + 4 * n + (i & 3); }

struct Unit { int z, pm, pn; };
struct Gemm { const bf16_t* A; const bf16_t* Bt; int lda, ldb, K; long sAz, sBz; };
struct Order {
    int nM, nN, nZ, G, c;
    DI bool next(int i, Unit& u) const {
        const long L = (long)i * G + c; const int per = nM * nN;
        if (c < 0 || L >= (long)per * nZ) return false;
        u.z = (int)(L / per); int wgid = (int)(L % per);
        if ((per & 63) == 0) {
            const int q = per >> 3, xcd = wgid & 7, off = wgid >> 3; wgid = xcd * q + off;
            const int nig = 8 * nN, gid = wgid / nig, fm = gid * 8, rem = nM - fm, gsz = rem < 8 ? rem : 8, wi = wgid % nig;
            u.pm = fm + wi % gsz; u.pn = wi / gsz;
        } else { u.pm = wgid / nN; u.pn = wgid % nN; }
        return true;
    }
};
typedef f32x4 Acc[2][2][4][2];

template <class Epi>
DI void gemm_phase_naive(const Gemm g, const Order& S, const Epi& E) {
    int tid_ = threadIdx.x; asm volatile("" : "+v"(tid_));
    const int tid = tid_, wid = tid >> 6, lane = tid & 63, wr = wid >> 2, wc = wid & 3, fr = lane & 15, fq = lane >> 4;
    Unit cur;
    for (int ui = 0; S.next(ui, cur); ++ui) {
        const bf16_t* Ab = g.A + (size_t)cur.z * g.sAz; const bf16_t* Bb = g.Bt + (size_t)cur.z * g.sBz;
        for (int am = 0; am < 8; ++am) {
            const int ai = am >> 2, m = am & 3;
            const int row = cur.pm * 256 + ai * 128 + wr * 64 + m * 16 + fr;
            float s[2][8];
            for (int bj = 0; bj < 2; ++bj) {
#pragma unroll
                for (int q = 0; q < 8; ++q) s[bj][q] = 0.f;
                const int col0 = cur.pn * 256 + bj * 128 + wc * 32 + 8 * fq;
                for (int k = 0; k < g.K; k += 8) {
                    float av[8]; unpack8(*(const u32x4*)(Ab + (size_t)row * g.lda + k), av);
#pragma unroll
                    for (int q = 0; q < 8; ++q) { float bv[8]; unpack8(*(const u32x4*)(Bb + (size_t)(col0 + q) * g.ldb + k), bv);
#pragma unroll
                        for (int e = 0; e < 8; ++e) s[bj][q] += av[e] * bv[e]; }
                }
            }
            E.naive(cur, row, wc, fq, (f32x4){s[0][0], s[0][1], s[0][2], s[0][3]}, (f32x4){s[0][4], s[0][5], s[0][6], s[0][7]}, (f32x4){s[1][0], s[1][1], s[1][2], s[1][3]}, (f32x4){s[1][4], s[1][5], s[1][6], s[1][7]});
        }
    }
}
template <class Epi, bool ALIGN_EPI>
DI void gemm_phase(LAS unsigned char* lds, const Gemm g, const Order& S, const Epi& E) {
#if DBG_NAIVE_GEMM
    gemm_phase_naive<Epi>(g, S, E); return;
#endif
    int tid_ = threadIdx.x; asm volatile("" : "+v"(tid_));
    const int tid = tid_, wid = __builtin_amdgcn_readfirstlane(tid >> 6), lane = tid & 63, wr = wid >> 2, wc = wid & 3, fr = lane & 15, fq = lane >> 4;
    const int K = g.K, nt = K / BK;
    unsigned voffA[2], voffB[2];
#pragma unroll
    for (int i = 0; i < 2; ++i) { int R, C; stage_rc(tid * 16 + i * 8192, R, C); const int Rb = (R & ~31) + perm32(R & 31);
        voffA[i] = (unsigned)(R * g.lda + C) * 2u; voffB[i] = (unsigned)(Rb * g.ldb + C) * 2u; }
    const size_t kstep = (size_t)(BK * 2);
    const size_t hA = (size_t)HALF * g.lda * 2, hB = (size_t)HALF * g.ldb * 2;
    const unsigned ldsw = (unsigned)wid * 1024u;
    const int aoff = lds_byte(wr * 64 + fr, fq * 8), boff = lds_byte(wc * 32 + fr, fq * 8);
#define PG8_SA(b, h) (((b) * 2 + (h)) * HTB)
#define PG8_SB(b, h) ((4 + (b) * 2 + (h)) * HTB)
#define PG8_STAGE(bufoff, gbase, voff) do { _Pragma("unroll") for (int _i = 0; _i < 2; ++_i) \
        __builtin_amdgcn_global_load_lds((const unsigned*)((const char*)(gbase) + (voff)[_i]), (LAS unsigned*)(lds + (bufoff) + ldsw + _i * 8192), 16, 0, 0); } while (0)
#define PG8_LDA(dst, b, h) do { _Pragma("unroll") for (int m = 0; m < 4; ++m) _Pragma("unroll") for (int k = 0; k < 2; ++k) dst[m][k] = *(const LAS bf16x8*)(lds + PG8_SA(b, h) + aoff + m * 2048 + k * 1024); } while (0)
#define PG8_LDB(dst, b, h) do { _Pragma("unroll") for (int n = 0; n < 2; ++n) _Pragma("unroll") for (int k = 0; k < 2; ++k) dst[n][k] = *(const LAS bf16x8*)(lds + PG8_SB(b, h) + boff + n * 2048 + k * 1024); } while (0)
#define PG8_MMA(ai, bj, At, Bt) do { __builtin_amdgcn_s_setprio(1); _Pragma("unroll") for (int m = 0; m < 4; ++m) _Pragma("unroll") for (int n = 0; n < 2; ++n) _Pragma("unroll") for (int k = 0; k < 2; ++k) \
        acc[ai][bj][m][n] = __builtin_amdgcn_mfma_f32_16x16x32_bf16(Bt[n][k], At[m][k], acc[ai][bj][m][n], 0, 0, 0); __builtin_amdgcn_s_setprio(0); } while (0)
#define PG8_WAIT_V(n) asm volatile("s_waitcnt vmcnt(" #n ")" ::: "memory")
#define PG8_WAIT_L(n) asm volatile("s_waitcnt lgkmcnt(" #n ")" ::: "memory")
#define PG8_BAR __builtin_amdgcn_s_barrier()
#define PG8_SCHED __builtin_amdgcn_sched_barrier(0)
    Unit cur, nxt; int ui = 0;
    if (!S.next(0, cur)) return;
    Acc acc;
#pragma unroll
    for (int a = 0; a < 2; ++a)
#pragma unroll
        for (int b = 0; b < 2; ++b)
#pragma unroll
            for (int m = 0; m < 4; ++m)
#pragma unroll
                for (int n = 0; n < 2; ++n) acc[a][b][m][n] = (f32x4){0.f, 0.f, 0.f, 0.f};
    bf16x8 At[4][2], B0[2][2], B1[2][2];
    const char* cA = (const char*)g.A + ((size_t)cur.z * g.sAz + (size_t)cur.pm * BM * g.lda) * 2;
    const char* cB = (const char*)g.Bt + ((size_t)cur.z * g.sBz + (size_t)cur.pn * BM * g.ldb) * 2;
    PG8_STAGE(PG8_SB(0, 0), cB, voffB); PG8_STAGE(PG8_SB(0, 1), cB + hB, voffB); PG8_STAGE(PG8_SA(0, 0), cA, voffA); PG8_STAGE(PG8_SA(0, 1), cA + hA, voffA);
    if (wr == 1) PG8_BAR;
    PG8_WAIT_V(2); PG8_BAR;
    PG8_STAGE(PG8_SB(1, 0), cB + kstep, voffB); PG8_STAGE(PG8_SA(1, 0), cA + kstep, voffA); PG8_STAGE(PG8_SB(1, 1), cB + hB + kstep, voffB);
    PG8_WAIT_V(6); PG8_BAR;
    for (;;) {
        const bool has_next = S.next(ui + 1, nxt);
        const char* nA = has_next ? (const char*)g.A + ((size_t)nxt.z * g.sAz + (size_t)nxt.pm * BM * g.lda) * 2 : cA;
        const char* nB = has_next ? (const char*)g.Bt + ((size_t)nxt.z * g.sBz + (size_t)nxt.pn * BM * g.ldb) * 2 : cB;
        for (int t = 0; t < nt; t += 2) {
            const bool last = (t == nt - 2);
            const char* a1 = cA + (size_t)(t + 1) * kstep;
            const char* a2 = last ? nA : cA + (size_t)(t + 2) * kstep; const char* b2 = last ? nB : cB + (size_t)(t + 2) * kstep;
            const char* a3 = a2 + kstep; const char* b3 = b2 + kstep;
            PG8_LDB(B0, 0, 0); PG8_LDB(B1, 0, 1); PG8_SCHED; PG8_LDA(At, 0, 0); PG8_STAGE(PG8_SA(1, 1), a1 + hA, voffA);
            PG8_WAIT_V(8); PG8_WAIT_L(0); PG8_BAR; PG8_MMA(0, 0, At, B0); PG8_MMA(0, 1, At, B1); PG8_BAR; PG8_SCHED;
            PG8_LDA(At, 0, 1); PG8_STAGE(PG8_SB(0, 0), b2, voffB); PG8_STAGE(PG8_SB(0, 1), b2 + hB, voffB); PG8_STAGE(PG8_SA(0, 0), a2, voffA);
            PG8_WAIT_V(8); PG8_WAIT_L(0); PG8_BAR; PG8_MMA(1, 0, At, B0); PG8_MMA(1, 1, At, B1); PG8_BAR; PG8_SCHED;
            PG8_LDB(B0, 1, 0); PG8_LDB(B1, 1, 1); PG8_SCHED; PG8_LDA(At, 1, 0); PG8_STAGE(PG8_SA(0, 1), a2 + hA, voffA);
            PG8_WAIT_V(8); PG8_WAIT_L(0); PG8_BAR; PG8_MMA(0, 0, At, B0); PG8_MMA(0, 1, At, B1); PG8_BAR; PG8_SCHED;
            PG8_LDA(At, 1, 1); PG8_STAGE(PG8_SB(1, 0), b3, voffB); PG8_STAGE(PG8_SB(1, 1), b3 + hB, voffB); PG8_STAGE(PG8_SA(1, 0), a3, voffA);
            PG8_WAIT_V(8); PG8_WAIT_L(0); PG8_BAR; PG8_MMA(1, 0, At, B0); PG8_MMA(1, 1, At, B1); PG8_BAR; PG8_SCHED;
        }
        if constexpr (ALIGN_EPI) { if (wr == 0) PG8_BAR; }
        E(acc, cur, wr, wc, fr, fq);
        if (!has_next) break;
#pragma unroll
        for (int a = 0; a < 2; ++a)
#pragma unroll
            for (int b = 0; b < 2; ++b)
#pragma unroll
                for (int m = 0; m < 4; ++m)
#pragma unroll
                    for (int n = 0; n < 2; ++n) acc[a][b][m][n] = (f32x4){0.f, 0.f, 0.f, 0.f};
        cur = nxt; cA = nA; cB = nB; ++ui;
        if constexpr (ALIGN_EPI) { if (wr == 1) PG8_BAR; }
    }
    PG8_WAIT_V(0);
    if constexpr (!ALIGN_EPI) { if (wr == 0) PG8_BAR; }
    PG8_BAR;
#undef PG8_SA
#undef PG8_SB
#undef PG8_STAGE
#undef PG8_LDA
#undef PG8_LDB
#undef PG8_MMA
#undef PG8_WAIT_V
#undef PG8_WAIT_L
#undef PG8_BAR
#undef PG8_SCHED
}

template <class E> DI void epi_rows_scaled(const E& e, const float* rs, const Acc& acc, const Unit& u, int wr, int wc, int fr, int fq) {
    float r[2][4];
#pragma unroll
    for (int ai = 0; ai < 2; ++ai)
#pragma unroll
        for (int m = 0; m < 4; ++m) r[ai][m] = rstd_of(rs, u.pm * 256 + ai * 128 + wr * 64 + m * 16 + fr);
#pragma unroll
    for (int ai = 0; ai < 2; ++ai)
#pragma unroll
        for (int m = 0; m < 4; ++m)
#pragma unroll
            for (int bj = 0; bj < 2; ++bj) {
                const int row = u.pm * 256 + ai * 128 + wr * 64 + m * 16 + fr; const int col0 = u.pn * 256 + bj * 128 + wc * 32 + 8 * fq;
                e.row8(u.z, row, col0, acc[ai][bj][m][0] * r[ai][m], acc[ai][bj][m][1] * r[ai][m]);
            }
}
template <class E> DI void epi_rows(const E& e, const Acc& acc, const Unit& u, int wr, int wc, int fr, int fq) {
#pragma unroll
    for (int ai = 0; ai < 2; ++ai)
#pragma unroll
        for (int m = 0; m < 4; ++m)
#pragma unroll
            for (int bj = 0; bj < 2; ++bj) {
                const int row = u.pm * 256 + ai * 128 + wr * 64 + m * 16 + fr; const int col0 = u.pn * 256 + bj * 128 + wc * 32 + 8 * fq;
                e.row8(u.z, row, col0, acc[ai][bj][m][0], acc[ai][bj][m][1]);
            }
}
struct EpiStore {
    bf16_t* O; int ldc; long sOz; const float* rs; const float* cs;
    DI void row8(int z, int row, int col0, f32x4 v0, f32x4 v1) const {
        if (cs) {
#pragma unroll
            for (int i = 0; i < 4; ++i) { v0[i] *= rstd_of(cs, col0 + i); v1[i] *= rstd_of(cs, col0 + 4 + i); } }
        *(u32x4*)(O + (size_t)z * sOz + (size_t)row * ldc + col0) = pack8(v0, v1); }
    DI void naive(const Unit& u, int row, int wc, int fq, const f32x4 a0, const f32x4 a1, const f32x4 b0, const f32x4 b1) const { row8(u.z, row, u.pn * 256 + wc * 32 + 8 * fq, a0, a1); row8(u.z, row, u.pn * 256 + 128 + wc * 32 + 8 * fq, b0, b1); }
    DI void operator()(const Acc& acc, const Unit& u, int wr, int wc, int fr, int fq) const { if (rs) epi_rows_scaled(*this, rs, acc, u, wr, wc, fr, fq); else epi_rows(*this, acc, u, wr, wc, fr, fq); }
};
struct EpiInProj {
    bf16_t* Ug; bf16_t* Big; float* Logits; const float* rs;
    DI void row8(int z, int row, int col0, const f32x4 v0, const f32x4 v1) const {
        if (col0 < 512) { const int g = col0 >> 4, c = col0 & 15, b = row >> 11, s = row & 2047, n = s >> 5, j = s & 31;
            *(u32x4*)(Ug + ((size_t)(g * S5ROWS + b * S5NCH + n)) * S5K + j * 16 + c) = pack8(v0, v1); }
        else if (col0 < 2560) { *(u32x4*)(Big + (size_t)row * ABPAD + col0) = pack8(v0, v1); }
        else if (col0 == 2560) { *(f32x4*)(Logits + (size_t)row * 8) = v0; *(f32x4*)(Logits + (size_t)row * 8 + 4) = v1; }
    }
    DI void naive(const Unit& u, int row, int wc, int fq, const f32x4 a0, const f32x4 a1, const f32x4 b0, const f32x4 b1) const { row8(u.z, row, u.pn * 256 + wc * 32 + 8 * fq, a0, a1); row8(u.z, row, u.pn * 256 + 128 + wc * 32 + 8 * fq, b0, b1); }
    DI void operator()(const Acc& acc, const Unit& u, int wr, int wc, int fr, int fq) const { epi_rows_scaled(*this, rs, acc, u, wr, wc, fr, fq); }
};
struct EpiResid {
    bf16_t* XB; float* OutF; float* PSn; LAS float* part;
    DI void operator()(const Acc& acc, const Unit& u, int wr, int wc, int fr, int fq) const {
#pragma unroll
        for (int ai = 0; ai < 2; ++ai)
#pragma unroll
            for (int m = 0; m < 4; ++m) {
                const int row = u.pm * 256 + ai * 128 + wr * 64 + m * 16 + fr; float s = 0.f;
#pragma unroll
                for (int bj = 0; bj < 2; ++bj) { const int col0 = u.pn * 256 + bj * 128 + wc * 32 + 8 * fq;
                    bf16_t* p = XB + (size_t)row * D + col0; float xv[8]; unpack8(*(const u32x4*)p, xv);
                    const f32x4 a = (f32x4){xv[0], xv[1], xv[2], xv[3]} + acc[ai][bj][m][0], b = (f32x4){xv[4], xv[5], xv[6], xv[7]} + acc[ai][bj][m][1];
                    if (OutF) { float* o = OutF + (size_t)row * D + col0; *(f32x4*)o = a; *(f32x4*)(o + 4) = b; } else *(u32x4*)p = pack8(a, b);
                    s += (a[0] * a[0] + a[1] * a[1]) + (a[2] * a[2] + a[3] * a[3]) + (b[0] * b[0] + b[1] * b[1]) + (b[2] * b[2] + b[3] * b[3]); }
                s += __shfl_xor(s, 16); s += __shfl_xor(s, 32);
                if (fq == 0) part[(ai * 128 + wr * 64 + m * 16 + fr) * 4 + wc] = s;
            }
        asm volatile("s_waitcnt lgkmcnt(0)" ::: "memory"); __builtin_amdgcn_s_barrier(); asm volatile("" ::: "memory");
        if (PSn) { const int t = threadIdx.x; if (t < 256) { const f32x4 p4 = *(const LAS f32x4*)(part + t * 4); PSn[(size_t)(u.pm * 256 + t) * 4 + u.pn] = (p4[0] + p4[1]) + (p4[2] + p4[3]); } }
        asm volatile("s_waitcnt lgkmcnt(0)" ::: "memory"); __builtin_amdgcn_s_barrier(); asm volatile("" ::: "memory");
    }
    DI void naive(const Unit& u, int row, int wc, int fq, const f32x4 a0, const f32x4 a1, const f32x4 b0, const f32x4 b1) const { }
};
struct EpiSwiglu {
    bf16_t* H; const float* rs;
    DI void naive(const Unit& u, int row, int wc, int fq, const f32x4 a0, const f32x4 a1, const f32x4 b0, const f32x4 b1) const {
        const int hid = u.pn * 128 + wc * 32 + 8 * fq; f32x4 h0, h1;
#pragma unroll
        for (int i = 0; i < 4; ++i) { h0[i] = siluf_(a0[i]) * b0[i]; h1[i] = siluf_(a1[i]) * b1[i]; }
        *(u32x4*)(H + (size_t)row * FF + hid) = pack8(h0, h1);
    }
    DI void operator()(const Acc& acc, const Unit& u, int wr, int wc, int fr, int fq) const {
        float rr[2][4];
#pragma unroll
        for (int ai = 0; ai < 2; ++ai)
#pragma unroll
            for (int m = 0; m < 4; ++m) rr[ai][m] = rstd_of(rs, u.pm * 256 + ai * 128 + wr * 64 + m * 16 + fr);
#pragma unroll
        for (int ai = 0; ai < 2; ++ai)
#pragma unroll
            for (int m = 0; m < 4; ++m) {
                const int row = u.pm * 256 + ai * 128 + wr * 64 + m * 16 + fr; const int hid = u.pn * 128 + wc * 32 + 8 * fq; const float r = rr[ai][m];
                f32x4 h0, h1;
#pragma unroll
                for (int i = 0; i < 4; ++i) { h0[i] = siluf_(acc[ai][0][m][0][i] * r) * acc[ai][1][m][0][i] * r; h1[i] = siluf_(acc[ai][0][m][1][i] * r) * acc[ai][1][m][1][i] * r; }
                *(u32x4*)(H + (size_t)row * FF + hid) = pack8(h0, h1);
            }
    }
};
struct EpiS5State {
    float* S;
    DI void row8(int z, int row, int col0, const f32x4 v0, const f32x4 v1) const { if (col0 < 128) { float* p = S + ((size_t)z * S5ROWS + row) * 128 + col0; *(f32x4*)p = v0; *(f32x4*)(p + 4) = v1; } }
    DI void naive(const Unit& u, int row, int wc, int fq, const f32x4 a0, const f32x4 a1, const f32x4 b0, const f32x4 b1) const { row8(u.z, row, u.pn * 256 + wc * 32 + 8 * fq, a0, a1); row8(u.z, row, u.pn * 256 + 128 + wc * 32 + 8 * fq, b0, b1); }
    DI void operator()(const Acc& acc, const Unit& u, int wr, int wc, int fr, int fq) const { epi_rows(*this, acc, u, wr, wc, fr, fq); }
};
struct EpiS5Y {
    const bf16_t* Ug; const float* dvec; bf16_t* Big;
    DI void row8(int z, int row, int col0, const f32x4 v0, const f32x4 v1) const {
        const int t = col0 >> 4, c = col0 & 15; const int token = (row >> 6) * SEQ + (row & 63) * S5L + t;
        const u32x4 uw = *(const u32x4*)(Ug + ((size_t)z * S5ROWS + row) * S5K + t * 16 + c); float uu[8]; unpack8(uw, uu);
        const f32x4 d0 = *(const f32x4*)(dvec + z * 16 + c); const f32x4 d1 = *(const f32x4*)(dvec + z * 16 + c + 4);
        f32x4 y0, y1;
#pragma unroll
        for (int i = 0; i < 4; ++i) { const float k_ = (DBG_SKIP & 32) ? 0.f : 1.f; y0[i] = gelu_tanh(k_ * v0[i] + d0[i] * uu[i]); y1[i] = gelu_tanh(k_ * v1[i] + d1[i] * uu[4 + i]); }
        *(u32x4*)(Big + (size_t)token * ABPAD + z * 16 + c) = pack8(y0, y1);
    }
    DI void naive(const Unit& u, int row, int wc, int fq, const f32x4 a0, const f32x4 a1, const f32x4 b0, const f32x4 b1) const { row8(u.z, row, u.pn * 256 + wc * 32 + 8 * fq, a0, a1); row8(u.z, row, u.pn * 256 + 128 + wc * 32 + 8 * fq, b0, b1); }
    DI void operator()(const Acc& acc, const Unit& u, int wr, int wc, int fr, int fq) const { epi_rows(*this, acc, u, wr, wc, fr, fq); }
};
struct EpiGlu {
    const bf16_t* Big; const float* bias; bf16_t* Mix;
    DI void row8(int z, int row, int col0, const f32x4 v0, const f32x4 v1) const {
        const u32x4 hw = *(const u32x4*)(Big + (size_t)row * ABPAD + col0); float hh[8]; unpack8(hw, hh);
        const f32x4 b0 = *(const f32x4*)(bias + col0); const f32x4 b1 = *(const f32x4*)(bias + col0 + 4);
        f32x4 o0, o1;
#pragma unroll
        for (int i = 0; i < 4; ++i) { o0[i] = hh[i] * sigmoidf_(v0[i] + b0[i]); o1[i] = hh[4 + i] * sigmoidf_(v1[i] + b1[i]); }
        if (DBG_SKIP & 4) { o0 = (f32x4){0.f,0.f,0.f,0.f}; o1 = o0; }
        if (DBG_HALF & 4) { o0 = o0 * DBG_A; o1 = o1 * DBG_A; }
        *(u32x4*)(Mix + (size_t)row * D + col0) = pack8(o0, o1);
    }
    DI void naive(const Unit& u, int row, int wc, int fq, const f32x4 a0, const f32x4 a1, const f32x4 b0, const f32x4 b1) const { row8(u.z, row, u.pn * 256 + wc * 32 + 8 * fq, a0, a1); row8(u.z, row, u.pn * 256 + 128 + wc * 32 + 8 * fq, b0, b1); }
    DI void operator()(const Acc& acc, const Unit& u, int wr, int wc, int fr, int fq) const { epi_rows(*this, acc, u, wr, wc, fr, fq); }
};
}

struct Ctx { LAS unsigned char* lds; int tid, lane, wave, gw, ngw; };
DI Ctx make_ctx(LAS unsigned char* lds) {
    Ctx C; int t = threadIdx.x; asm volatile("" : "+v"(t));
    C.lds = lds; C.tid = t; C.lane = t & 63; C.wave = __builtin_amdgcn_readfirstlane(t >> 6);
    C.gw = blockIdx.x * NWAVES + C.wave; C.ngw = gridDim.x * NWAVES; return C;
}

DI void tr_item(const float* W, int K, int N, int ldw, int n_off, bf16_t* WT, int row_off, int grp, int gstride, LAS float* scr, int item, int lane, const float* gain = nullptr) {
    const int nblk = (N + 31) / 32, kb = item / nblk, nb = item % nblk, k0 = 64 * kb, n0 = 32 * nb;
    const int rr = lane >> 3, cc = (lane & 7) * 4; const bool ok = (n0 + cc) < N;
    f32x4 v[8];
#pragma unroll
    for (int i = 0; i < 8; ++i) { const f32x4 t4 = *(const f32x4*)(W + (size_t)(k0 + 8 * i + rr) * ldw + n_off + n0 + (ok ? cc : 0)); v[i] = ok ? t4 : (f32x4){0.f, 0.f, 0.f, 0.f}; }
#pragma unroll
    for (int i = 0; i < 8; ++i) { const int kk = 8 * i + rr; const float gk = gain ? gain[k0 + kk] : 1.f; LAS float* sp = scr + kk * 33 + cc; sp[0] = v[i][0] * gk; sp[1] = v[i][1] * gk; sp[2] = v[i][2] * gk; sp[3] = v[i][3] * gk; }
    asm volatile("s_waitcnt lgkmcnt(0)" ::: "memory");
    const int c = lane & 7;
#pragma unroll
    for (int j = 0; j < 4; ++j) { const int n = (lane >> 3) + 8 * j; const LAS float* s = scr + (8 * c) * 33 + n;
        u32x4 o; o.x = cvt_pk_bf16(s[0 * 33], s[1 * 33]); o.y = cvt_pk_bf16(s[2 * 33], s[3 * 33]); o.z = cvt_pk_bf16(s[4 * 33], s[5 * 33]); o.w = cvt_pk_bf16(s[6 * 33], s[7 * 33]);
        const int q = n0 + n; const int drow = row_off + (q / grp) * gstride + (q % grp);
        *(u32x4*)(WT + (size_t)drow * K + k0 + 8 * c) = o; }
    asm volatile("s_waitcnt lgkmcnt(0)" ::: "memory");
}
DI void conv_mat(const Ctx& C, const float* W, int K, int N, int ldw, int n_off, bf16_t* WT, int row_off, int grp, int gstride) {
#if DBG_NAIVE
    { const size_t tot = (size_t)K * N; const size_t stride = (size_t)C.ngw * 64;
      for (size_t idx = (size_t)C.gw * 64 + C.lane; idx < tot; idx += stride) { const int n = (int)(idx / K), k = (int)(idx % K);
          const int drow = row_off + (n / grp) * gstride + (n % grp); WT[(size_t)drow * K + k] = f2bf(W[(size_t)k * ldw + n_off + n]); }
      return; }
#endif
    LAS float* scr = (LAS float*)(C.lds + C.wave * 16384);
    const int items = (K / 64) * ((N + 31) / 32);
    for (int it = C.gw; it < items; it += C.ngw) tr_item(W, K, N, ldw, n_off, WT, row_off, grp, gstride, scr, it, C.lane);
}
DI void rms_rows(const Ctx& C, const float* X, const float* gain, bf16_t* O, int rows) {
#if DBG_NAIVE
    { const int gt = C.gw * 64 + C.lane, nth = C.ngw * 64;
      for (int r = gt; r < rows; r += nth) { const float* xr = X + (size_t)r * D; float s = 0.f; for (int k = 0; k < D; ++k) s += xr[k] * xr[k];
          const float rstd = 1.0f / sqrtf(s / (float)D + EPS); for (int k = 0; k < D; ++k) O[(size_t)r * D + k] = f2bf(xr[k] * rstd * gain[k]); }
      return; }
#endif
    const f32x4 g0 = *(const f32x4*)(gain + 4 * C.lane), g1 = *(const f32x4*)(gain + 256 + 4 * C.lane), g2 = *(const f32x4*)(gain + 512 + 4 * C.lane), g3 = *(const f32x4*)(gain + 768 + 4 * C.lane);
    for (int r = C.gw; r < rows; r += C.ngw) {
        const f32x4* xr = (const f32x4*)(X + (size_t)r * D) + C.lane;
        f32x4 v0 = xr[0], v1 = xr[64], v2 = xr[128], v3 = xr[192];
        float s = (v0[0]*v0[0] + v0[1]*v0[1]) + (v0[2]*v0[2] + v0[3]*v0[3]) + (v1[0]*v1[0] + v1[1]*v1[1]) + (v1[2]*v1[2] + v1[3]*v1[3])
                + (v2[0]*v2[0] + v2[1]*v2[1]) + (v2[2]*v2[2] + v2[3]*v2[3]) + (v3[0]*v3[0] + v3[1]*v3[1]) + (v3[2]*v3[2] + v3[3]*v3[3]);
        const float rstd = rsqrtf(wave_sum(s) * (1.f / D) + EPS);
        v0 = v0 * rstd * g0; v1 = v1 * rstd * g1; v2 = v2 * rstd * g2; v3 = v3 * rstd * g3;
        u32x2* o = (u32x2*)(O + (size_t)r * D) + C.lane;
        o[0]   = (u32x2){cvt_pk_bf16(v0[0], v0[1]), cvt_pk_bf16(v0[2], v0[3])};
        o[64]  = (u32x2){cvt_pk_bf16(v1[0], v1[1]), cvt_pk_bf16(v1[2], v1[3])};
        o[128] = (u32x2){cvt_pk_bf16(v2[0], v2[1]), cvt_pk_bf16(v2[2], v2[3])};
        o[192] = (u32x2){cvt_pk_bf16(v3[0], v3[1]), cvt_pk_bf16(v3[2], v3[3])};
    }
}
DI void rms_rows_b(const Ctx& C, const bf16_t* Xb, const float* gain, bf16_t* O, int rows) {
    f32x4 g[4];
#pragma unroll
    for (int j = 0; j < 4; ++j) g[j] = *(const f32x4*)(gain + 256 * j + 4 * C.lane);
    for (int r = C.gw; r < rows; r += C.ngw) {
        const u32x2* xr = (const u32x2*)(Xb + (size_t)r * D) + C.lane; f32x4 v[4]; float s = 0.f;
#pragma unroll
        for (int j = 0; j < 4; ++j) { const u32x2 w = xr[64 * j]; v[j] = (f32x4){bflo(w.x), bfhi(w.x), bflo(w.y), bfhi(w.y)}; s += (v[j][0] * v[j][0] + v[j][1] * v[j][1]) + (v[j][2] * v[j][2] + v[j][3] * v[j][3]); }
        const float rstd = rsqrtf(wave_sum(s) * (1.f / D) + EPS);
        u32x2* o = (u32x2*)(O + (size_t)r * D) + C.lane;
#pragma unroll
        for (int j = 0; j < 4; ++j) { const f32x4 y = v[j] * rstd * g[j]; o[64 * j] = (u32x2){cvt_pk_bf16(y[0], y[1]), cvt_pk_bf16(y[2], y[3])}; }
    }
}
DI void x_prep(const Ctx& C, const float* Xin, bf16_t* XB, float* PS0) {
    for (int r = C.gw; r < M; r += C.ngw) {
        const f32x4* xr = (const f32x4*)(Xin + (size_t)r * D) + C.lane; u32x2* xb = (u32x2*)(XB + (size_t)r * D) + C.lane; float s = 0.f;
#pragma unroll
        for (int j = 0; j < 4; ++j) { const f32x4 v = xr[64 * j]; xb[64 * j] = (u32x2){cvt_pk_bf16(v[0], v[1]), cvt_pk_bf16(v[2], v[3])}; s += (v[0] * v[0] + v[1] * v[1]) + (v[2] * v[2] + v[3] * v[3]); }
        s = wave_sum(s); if (C.lane < 4) PS0[(size_t)r * 4 + C.lane] = C.lane == 0 ? s : 0.f;
    }
}
DI void copy_f32(const Ctx& C, const float* src, float* dst, size_t n4) {
    const size_t stride = (size_t)C.ngw * 64;
    for (size_t i = (size_t)C.gw * 64 + C.lane; i < n4; i += stride) ((f32x4*)dst)[i] = ((const f32x4*)src)[i];
}
DI void knorm_phase(const Ctx& C, bf16_t* KALL, const float* kg  ) {
    for (int r = C.gw; r < MMEM * 16; r += C.ngw) {
        const int tok = r >> 4, lh = r & 15, layer = lh >> 2;
        u32x2* p = (u32x2*)(KALL + (size_t)tok * 4096 + lh * 256) + C.lane;
        const u32x2 w = *p; float v0 = bflo(w.x), v1 = bfhi(w.x), v2 = bflo(w.y), v3 = bfhi(w.y);
        const float rstd = rsqrtf(wave_sum(v0 * v0 + v1 * v1 + v2 * v2 + v3 * v3) * (1.f / 256.f) + EPS);
        const f32x4 g = *(const f32x4*)(kg + layer * 256 + 4 * C.lane);
        *p = (u32x2){cvt_pk_bf16(v0 * rstd * g[0], v1 * rstd * g[1]), cvt_pk_bf16(v2 * rstd * g[2], v3 * rstd * g[3])};
    }
}

DI void s5_build(const Ctx& C, const float* a_re, const float* a_im, const float* log_dt, const float* b_re, const float* b_im, const float* c_re, const float* c_im, bf16_t* T, bf16_t* Bm) {
    LAS float* lamr = (LAS float*)C.lds; LAS float* lami = lamr + 64; LAS float* Bre = lami + 64; LAS float* Bim = Bre + 1024; LAS float* Cre = Bim + 1024; LAS float* Cim = Cre + 1024;
    LAS unsigned short* Kd = (LAS unsigned short*)(Cim + 1024);
    for (int u = C.gw / NWAVES; u < 32 * 8; u += C.ngw / NWAVES) {
        const int g = u >> 3, part = u & 7, tlo = part * 4;
        __syncthreads();
        const float dt = __expf(log_dt[g]);
        if (C.tid < 64) { const int p = C.tid; const float ar = a_re[g * 64 + p], ai = a_im[g * 64 + p]; float sn, cs; sincosf(ai * dt, &sn, &cs); const float mag = __expf(ar * dt); lamr[p] = mag * cs; lami[p] = mag * sn; }
        for (int e = C.tid; e < 1024; e += NTHR) { Cre[e] = c_re[(size_t)g * 1024 + e]; Cim[e] = c_im[(size_t)g * 1024 + e]; }
        __syncthreads();
        for (int e = C.tid; e < 1024; e += NTHR) { const int p = e >> 4; const float ar = a_re[g * 64 + p], ai = a_im[g * 64 + p];
            const float nr = lamr[p] - 1.f, ni = lami[p]; const float inv = 1.f / (ar * ar + ai * ai);
            const float qr = (nr * ar + ni * ai) * inv, qi = (ni * ar - nr * ai) * inv;
            const float br = b_re[(size_t)g * 1024 + e], bi = b_im[(size_t)g * 1024 + e];
            Bre[e] = qr * br - qi * bi; Bim[e] = qr * bi + qi * br; }
        __syncthreads();
        for (int pass = 0; pass < 2; ++pass) { const int entry = pass * 128 + (C.tid >> 2), qt = C.tid & 3, c = entry >> 4, cp = entry & 15;
          float wr_[16], wi_[16];
#pragma unroll
          for (int k = 0; k < 16; ++k) { const int p = 16 * qt + k; wr_[k] = Bre[p * 16 + cp]; wi_[k] = Bim[p * 16 + cp]; }
          for (int dl = 0; dl <= tlo + 3; ++dl) {
              float s = 0.f;
#pragma unroll
              for (int k = 0; k < 16; ++k) { const int p = 16 * qt + k; s += Cre[c * 64 + p] * wr_[k] - Cim[c * 64 + p] * wi_[k];
                  const float nr = wr_[k] * lamr[p] - wi_[k] * lami[p], ni = wr_[k] * lami[p] + wi_[k] * lamr[p]; wr_[k] = nr; wi_[k] = ni; }
              s += __shfl_xor(s, 1); s += __shfl_xor(s, 2);
              if (qt == 0) Kd[dl * 256 + entry] = f2bf(s);
          } }
        __syncthreads();
        for (int idx = C.tid; idx < 4 * 16 * 64; idx += NTHR) { const int hf = idx & 1, j = (idx >> 1) & 31, c = (idx >> 6) & 15, t = tlo + (idx >> 10);
            u32x4 w = (u32x4){0u, 0u, 0u, 0u}; if (j <= t) w = *(const LAS u32x4*)(Kd + (t - j) * 256 + c * 16 + hf * 8);
            *(u32x4*)(T + ((size_t)g * 512 + t * 16 + c) * S5K + j * 16 + hf * 8) = w; }
        for (int e = C.tid; e < 1024; e += NTHR) {
            { const int c = e >> 6, p = e & 63; float er = lamr[p], ei = lami[p];
              for (int k = 0; k < tlo; ++k) { const float nr = er * lamr[p] - ei * lami[p], ni = er * lami[p] + ei * lamr[p]; er = nr; ei = ni; }
              const float cr = Cre[e], ci = Cim[e];
              for (int t = tlo; t < tlo + 4; ++t) { *(unsigned*)(T + ((size_t)g * 512 + t * 16 + c) * S5K + 512 + 2 * p) = cvt_pk_bf16(cr * er - ci * ei, -(cr * ei + ci * er));
                  const float nr = er * lamr[p] - ei * lami[p], ni = er * lami[p] + ei * lamr[p]; er = nr; ei = ni; } }
            { const int p = e >> 4, cp = e & 15; float er = 1.f, ei = 0.f;
              for (int k = 0; k < 31 - (tlo + 3); ++k) { const float nr = er * lamr[p] - ei * lami[p], ni = er * lami[p] + ei * lamr[p]; er = nr; ei = ni; }
              const float br = Bre[e], bi = Bim[e];
              for (int j = tlo + 3; j >= tlo; --j) { Bm[((size_t)g * 256 + 2 * p) * 512 + j * 16 + cp] = f2bf(er * br - ei * bi); Bm[((size_t)g * 256 + 2 * p + 1) * 512 + j * 16 + cp] = f2bf(er * bi + ei * br);
                  const float nr = er * lamr[p] - ei * lami[p], ni = er * lami[p] + ei * lamr[p]; er = nr; ei = ni; } }
        }
    }
    __syncthreads();
}
DI void s5_scan(const Ctx& C, const float* a_re, const float* a_im, const float* log_dt, const float* S, bf16_t* Ug) {
    const int gt = blockIdx.x * NTHR + C.tid;
    if (gt < BATCH * 32 * 64) {
        const int p = gt & 63, g = (gt >> 6) & 31, b = gt >> 11;
        const float dt = __expf(log_dt[g]); const float ar = a_re[g * 64 + p], ai = a_im[g * 64 + p];
        float sn, cs; sincosf(ai * dt * 32.f, &sn, &cs); const float mag = __expf(ar * dt * 32.f); const float lr = mag * cs, li = mag * sn;
        float xr = 0.f, xi = 0.f;
        const size_t row0 = (size_t)g * S5ROWS + b * S5NCH;
        for (int nb = 0; nb < S5NCH; nb += 32) {
            f32x2 sv[32];
#pragma unroll
            for (int j = 0; j < 32; ++j) sv[j] = *(const f32x2*)(S + (row0 + nb + j) * 128 + 2 * p);
#pragma unroll
            for (int j = 0; j < 32; ++j) {
                *(unsigned*)(Ug + (row0 + nb + j) * S5K + 512 + 2 * p) = cvt_pk_bf16(xr, xi);
                const float nr = lr * xr - li * xi + sv[j][0], ni = lr * xi + li * xr + sv[j][1]; xr = nr; xi = ni;
            }
        }
    }
}

DI void gdn_pre(const Ctx& C, const bf16_t* Big, const float* Logits, const float* conv_w  , const float* a_log, const float* dt_bias, unsigned char* scr, unsigned char* hn) {
    constexpr int LD = 129;
    constexpr int LB = 136;
    LAS float* kf = (LAS float*)C.lds; LAS float* vf = kf + 64 * LD; LAS float* qf = vf + 64 * LD; LAS float* Lm = qf;
    LAS bf16_t* qb = (LAS bf16_t*)(qf + 64 * LD); LAS bf16_t* kb = qb + 64 * LB; LAS float* gc = (LAS float*)(kb + 64 * LB); LAS float* be = gc + 64;
    bf16_t* WK = (bf16_t*)(hn + HN_WK); bf16_t* UT = (bf16_t*)(scr + SC_UT); bf16_t* QG = (bf16_t*)(scr + SC_QG); bf16_t* KT = (bf16_t*)(hn + HN_KT); bf16_t* QK = (bf16_t*)(scr + SC_QK); float* DEC = (float*)(scr + SC_DEC);
    for (int u = blockIdx.x; u < BATCH * 4 * 32; u += gridDim.x) {
        const int b = u >> 7, h = (u >> 5) & 3, n = u & 31; const int tok0 = b * SEQ + n * 64;
        __syncthreads();
        { const int d = C.tid & 127, tq = C.tid >> 7, t0 = tq * 16; const int s0 = n * 64 + t0;
          float xin[3][19];
#pragma unroll
          for (int part = 0; part < 3; ++part) { const bf16_t* src = Big + 512 + part * 512 + h * 128 + d;
#pragma unroll
              for (int i = 0; i < 19; ++i) { const int si = s0 - 3 + i, sc_ = si < 0 ? 0 : si; const float xv = bf2f(src[(size_t)(b * SEQ + sc_) * ABPAD]); xin[part][i] = si < 0 ? 0.f : xv; } }
#pragma unroll
          for (int part = 0; part < 3; ++part) {
              const int ch = part * 512 + h * 128 + d; const float w0 = conv_w[ch], w1 = conv_w[1536 + ch], w2 = conv_w[2 * 1536 + ch], w3 = conv_w[3 * 1536 + ch];
              LAS float* dst = part == 0 ? qf : (part == 1 ? kf : vf);
#pragma unroll
              for (int i = 0; i < 16; ++i) { const float y = w0 * xin[part][i] + w1 * xin[part][i + 1] + w2 * xin[part][i + 2] + w3 * xin[part][i + 3]; dst[(t0 + i) * LD + d] = siluf_(y); }
          } }
        if (C.wave == 0) { const int t = C.lane; const float a = Logits[(size_t)(tok0 + t) * 8 + h], bl = Logits[(size_t)(tok0 + t) * 8 + 4 + h];
            const float x = a + dt_bias[h]; const float sp = x > 20.f ? x : log1pf(__expf(x)); float gv = -__expf(a_log[h]) * sp;
#pragma unroll
            for (int o = 1; o < 64; o <<= 1) { const float y = __shfl_up(gv, o); if (t >= o) gv += y; }
            gc[t] = gv; be[t] = sigmoidf_(bl); }
        __syncthreads();
        for (int r = C.wave; r < 128; r += NWAVES) { LAS float* rowp = (r < 64 ? qf + r * LD : kf + (r - 64) * LD); const float v0 = rowp[C.lane], v1 = rowp[C.lane + 64];
            const float sc = rsqrtf(wave_sum(v0 * v0 + v1 * v1) + EPS) * (r < 64 ? 0.08838834764831845f : 1.f); rowp[C.lane] = v0 * sc; rowp[C.lane + 64] = v1 * sc;
            LAS bf16_t* bp = (r < 64 ? qb + r * LB : kb + (r - 64) * LB); bp[C.lane] = f2bf(v0 * sc); bp[C.lane + 64] = f2bf(v1 * sc); }
        __syncthreads();
        { const int w = C.wave, mt = w >> 1, l15 = C.lane & 15, lq = C.lane >> 4;
          f32x4 akk[2], aqk[2];
#pragma unroll
          for (int q2 = 0; q2 < 2; ++q2) { akk[q2] = (f32x4){0.f, 0.f, 0.f, 0.f}; aqk[q2] = akk[q2]; }
#pragma unroll
          for (int ks = 0; ks < 4; ++ks) { const bf16x8 af = *(const LAS bf16x8*)(kb + (16 * mt + l15) * LB + 32 * ks + 8 * lq);
#pragma unroll
              for (int q2 = 0; q2 < 2; ++q2) { const int nt = (w & 1) * 2 + q2;
                  const bf16x8 bk = *(const LAS bf16x8*)(kb + (16 * nt + l15) * LB + 32 * ks + 8 * lq), bq = *(const LAS bf16x8*)(qb + (16 * nt + l15) * LB + 32 * ks + 8 * lq);
                  akk[q2] = __builtin_amdgcn_mfma_f32_16x16x32_bf16(af, bk, akk[q2], 0, 0, 0); aqk[q2] = __builtin_amdgcn_mfma_f32_16x16x32_bf16(af, bq, aqk[q2], 0, 0, 0); } }
          __syncthreads();
#pragma unroll
          for (int q2 = 0; q2 < 2; ++q2) { const int nt = (w & 1) * 2 + q2;
              { const int j = 16 * nt + l15; const float gj = gc[j]; f32x4 lv;
#pragma unroll
                for (int i = 0; i < 4; ++i) { const int t = 16 * mt + 4 * lq + i; lv[i] = (t > j) ? be[t] * akk[q2][i] * __expf(gc[t] - gj) : 0.f; }
                *(LAS f32x4*)(Lm + j * 64 + 16 * mt + 4 * lq) = lv; }
              { const int t = 16 * nt + l15; const float gt_ = gc[t]; f32x4 qv;
#pragma unroll
                for (int i = 0; i < 4; ++i) { const int j = 16 * mt + 4 * lq + i; qv[i] = (t >= j) ? aqk[q2][i] * __expf(gt_ - gc[j]) : 0.f; }
                *(u32x2*)(QK + (size_t)u * 4096 + t * 64 + 16 * mt + 4 * lq) = (u32x2){cvt_pk_bf16(qv[0], qv[1]), cvt_pk_bf16(qv[2], qv[3])}; } } }
        __syncthreads();
        { const float glast = gc[63];
          for (int e = C.tid; e < 64 * 16; e += NTHR) { const int t = e >> 4, d0 = (e & 15) * 8; const float gm = __expf(gc[t]); f32x4 a, b2;
#pragma unroll
              for (int i = 0; i < 4; ++i) { a[i] = bf2f(qb[t * LB + d0 + i]) * gm; b2[i] = bf2f(qb[t * LB + d0 + 4 + i]) * gm; }
              *(u32x4*)(QG + (size_t)u * 8192 + t * 128 + d0) = pack8(a, b2); }
          for (int e = C.tid; e < 128 * 8; e += NTHR) { const int d = e >> 3, t0 = (e & 7) * 8; f32x4 a, b2;
#pragma unroll
              for (int i = 0; i < 4; ++i) { a[i] = kf[(t0 + i) * LD + d] * __expf(glast - gc[t0 + i]); b2[i] = kf[(t0 + 4 + i) * LD + d] * __expf(glast - gc[t0 + 4 + i]); }
              *(u32x4*)(KT + (size_t)u * 8192 + d * 64 + t0) = pack8(a, b2); }
          if (C.tid == 0) DEC[u] = __expf(glast); }
        __syncthreads();
        if (C.tid < 256) {
            const int col = C.tid; LAS float* base = (col < 128) ? (vf + col) : (kf + (col - 128));
            for (int tb = 0; tb < 4; ++tb) {
                float acc[16];
#pragma unroll
                for (int i = 0; i < 16; ++i) { const int t = tb * 16 + i; const float sc = (col < 128) ? be[t] : be[t] * __expf(gc[t]); acc[i] = base[t * LD] * sc; }
                for (int j = 0; j < tb * 16; ++j) { const float s = base[j * LD]; const LAS f32x4* lp = (const LAS f32x4*)(Lm + j * 64 + tb * 16);
                    const f32x4 l0 = lp[0], l1 = lp[1], l2 = lp[2], l3 = lp[3];
#pragma unroll
                    for (int i = 0; i < 4; ++i) { acc[i] -= l0[i] * s; acc[4 + i] -= l1[i] * s; acc[8 + i] -= l2[i] * s; acc[12 + i] -= l3[i] * s; } }
#pragma unroll
                for (int j = 0; j < 15; ++j) { const float s = acc[j]; const LAS float* lp = Lm + (tb * 16 + j) * 64 + tb * 16;
#pragma unroll
                    for (int i = j + 1; i < 16; ++i) acc[i] -= lp[i] * s; }
#pragma unroll
                for (int i = 0; i < 16; ++i) base[(tb * 16 + i) * LD] = acc[i];
            }
        }
        __syncthreads();
        for (int e = C.tid; e < 128 * 8; e += NTHR) { const int ee = e >> 3, t0 = (e & 7) * 8;
            *(u32x4*)(UT + (size_t)u * 8192 + ee * 64 + t0) = pack8((f32x4){vf[t0 * LD + ee], vf[(t0 + 1) * LD + ee], vf[(t0 + 2) * LD + ee], vf[(t0 + 3) * LD + ee]}, (f32x4){vf[(t0 + 4) * LD + ee], vf[(t0 + 5) * LD + ee], vf[(t0 + 6) * LD + ee], vf[(t0 + 7) * LD + ee]}); }
        for (int e = C.tid; e < 64 * 16; e += NTHR) { const int t = e >> 4, d0 = (e & 15) * 8; f32x4 a, b2;
#pragma unroll
            for (int i = 0; i < 4; ++i) { a[i] = kf[t * LD + d0 + i]; b2[i] = kf[t * LD + d0 + 4 + i]; }
            *(u32x4*)(WK + (size_t)u * 8192 + t * 128 + d0) = pack8(a, b2); }
    }
    __syncthreads();
}
DI void gdn_seq(const Ctx& C, const unsigned char* scr, const unsigned char* hn, float* GO  ) {
    const bf16_t* WK = (const bf16_t*)(hn + HN_WK); const bf16_t* UT = (const bf16_t*)(scr + SC_UT); const bf16_t* QG = (const bf16_t*)(scr + SC_QG); const bf16_t* KT = (const bf16_t*)(hn + HN_KT); const bf16_t* QK = (const bf16_t*)(scr + SC_QK); const float* DEC = (const float*)(scr + SC_DEC);
    constexpr int STLD = 136, WTLD = 72;
    LAS bf16_t* ST = (LAS bf16_t*)C.lds; LAS bf16_t* WT = ST + 16 * STLD; LAS float* decs = (LAS float*)(WT + 16 * WTLD);
    const int w = C.wave, l15 = C.lane & 15, lq = C.lane >> 4;
    for (int blk = blockIdx.x; blk < BATCH * 4 * 8; blk += gridDim.x) {
        const int bh = blk >> 3, es = blk & 7, b = bh >> 2, h = bh & 3;
        f32x4 Sreg = (f32x4){0.f, 0.f, 0.f, 0.f};
        __syncthreads();
        *(LAS u32x2*)(ST + l15 * STLD + 16 * w + 4 * lq) = (u32x2){0u, 0u};
        if (C.tid < 32) { int idx = bh * 32 + C.tid; asm volatile("" : "+v"(idx)); decs[C.tid] = DEC[idx]; }
        __syncthreads();
        const int mt = w & 3;
        bf16x8 a1[4], a2[2], a3[2]; u32x2 uw = (u32x2){0u, 0u}; float dec = 0.f; a2[0] = (bf16x8){0, 0, 0, 0, 0, 0, 0, 0}; a2[1] = a2[0];
#define GS_LOAD(n_) do { const size_t u_ = (size_t)bh * 32 + (n_); \
            const bf16_t* As_ = (w < 4 ? WK : QG) + u_ * 8192 + (16 * mt + l15) * 128 + 8 * lq; \
            _Pragma("unroll") for (int ks = 0; ks < 4; ++ks) a1[ks] = *(const bf16x8*)(As_ + 32 * ks); \
            if (w >= 4) { _Pragma("unroll") for (int ks = 0; ks < 2; ++ks) a2[ks] = *(const bf16x8*)(QK + u_ * 4096 + (16 * mt + l15) * 64 + 32 * ks + 8 * lq); } \
            else uw = *(const u32x2*)(UT + u_ * 8192 + (es * 16 + l15) * 64 + 16 * mt + 4 * lq); \
            _Pragma("unroll") for (int ks = 0; ks < 2; ++ks) a3[ks] = *(const bf16x8*)(KT + u_ * 8192 + (16 * w + l15) * 64 + 32 * ks + 8 * lq); \
            dec = decs[(n_)]; } while (0)
        GS_LOAD(0);
        for (int n = 0; n < 32; ++n) {
            bf16x8 c1[4], c2[2], c3[2];
#pragma unroll
            for (int ks = 0; ks < 4; ++ks) c1[ks] = a1[ks];
#pragma unroll
            for (int ks = 0; ks < 2; ++ks) { c2[ks] = a2[ks]; c3[ks] = a3[ks]; }
            u32x2 cuw = uw; float cdec = dec;
#pragma unroll
            for (int ks = 0; ks < 4; ++ks) asm volatile("" : "+v"(c1[ks]));
#pragma unroll
            for (int ks = 0; ks < 2; ++ks) asm volatile("" : "+v"(c2[ks]), "+v"(c3[ks]));
            asm volatile("" : "+v"(cuw), "+v"(cdec));
            if (n + 1 < 32) GS_LOAD(n + 1);
            f32x4 acc = (f32x4){0.f, 0.f, 0.f, 0.f};
#pragma unroll
            for (int ks = 0; ks < 4; ++ks) { const bf16x8 bb = *(const LAS bf16x8*)(ST + l15 * STLD + 32 * ks + 8 * lq); acc = __builtin_amdgcn_mfma_f32_16x16x32_bf16(c1[ks], bb, acc, 0, 0, 0); }
            if (w < 4) { const f32x4 uu = (f32x4){bflo(cuw.x), bfhi(cuw.x), bflo(cuw.y), bfhi(cuw.y)}; const f32x4 wv = uu - acc;
                *(LAS u32x2*)(WT + l15 * WTLD + 16 * mt + 4 * lq) = (u32x2){cvt_pk_bf16(wv[0], wv[1]), cvt_pk_bf16(wv[2], wv[3])}; }
            asm volatile("s_waitcnt lgkmcnt(0)" ::: "memory"); __builtin_amdgcn_s_barrier(); asm volatile("" ::: "memory");
            bf16x8 wb[2];
#pragma unroll
            for (int ks = 0; ks < 2; ++ks) wb[ks] = *(const LAS bf16x8*)(WT + l15 * WTLD + 32 * ks + 8 * lq);
            if (w >= 4) {
#pragma unroll
                for (int ks = 0; ks < 2; ++ks) acc = __builtin_amdgcn_mfma_f32_16x16x32_bf16(c2[ks], wb[ks], acc, 0, 0, 0);
                float* o = GO + (size_t)(b * SEQ + n * 64 + 16 * mt + 4 * lq) * 512 + h * 128 + es * 16 + l15;
#pragma unroll
                for (int i = 0; i < 4; ++i) o[(size_t)i * 512] = acc[i];
            }
            { f32x4 sn = Sreg * cdec;
#pragma unroll
              for (int ks = 0; ks < 2; ++ks) sn = __builtin_amdgcn_mfma_f32_16x16x32_bf16(c3[ks], wb[ks], sn, 0, 0, 0);
              Sreg = sn; }
            *(LAS u32x2*)(ST + l15 * STLD + 16 * w + 4 * lq) = (u32x2){cvt_pk_bf16(Sreg[0], Sreg[1]), cvt_pk_bf16(Sreg[2], Sreg[3])};
            asm volatile("s_waitcnt lgkmcnt(0)" ::: "memory"); __builtin_amdgcn_s_barrier(); asm volatile("" ::: "memory");
        }
#undef GS_LOAD
    }
    __syncthreads();
}
DI void gdn_post(const Ctx& C, const float* GO, const bf16_t* Big, const float* out_g, bf16_t* Mix) {
    const f32x2 g = *(const f32x2*)(out_g + 2 * C.lane);
    for (int tok = C.gw; tok < M; tok += C.ngw) {
        f32x2 o[4];
#pragma unroll
        for (int h = 0; h < 4; ++h) o[h] = *(const f32x2*)(GO + (size_t)tok * 512 + h * 128 + 2 * C.lane);
        float ss[4];
#pragma unroll
        for (int h = 0; h < 4; ++h) ss[h] = wave_sum(o[h][0] * o[h][0] + o[h][1] * o[h][1]);
        unsigned outw[4];
#pragma unroll
        for (int h = 0; h < 4; ++h) { const float rstd = rsqrtf(ss[h] * (1.f / 128.f) + EPS);
            const unsigned gw_ = *(const unsigned*)(Big + (size_t)tok * ABPAD + 2048 + h * 128 + 2 * C.lane);
            outw[h] = cvt_pk_bf16(o[h][0] * rstd * g[0] * siluf_(bflo(gw_)), o[h][1] * rstd * g[1] * siluf_(bfhi(gw_))); }
        asm volatile("" ::: "memory");
#pragma unroll
        for (int h = 0; h < 4; ++h) *(unsigned*)(Mix + (size_t)tok * D + 512 + h * 128 + 2 * C.lane) = outw[h];
    }
}

#define MFMA32(a, b, c) __builtin_amdgcn_mfma_f32_32x32x16_bf16((a), (b), (c), 0, 0, 0)
DI bf16x8 mk8(unsigned a, unsigned b, unsigned c, unsigned d) { return __builtin_bit_cast(bf16x8, (u32x4){a, b, c, d}); }

DI void chunk_attn(const Ctx& C, const bf16_t* QKb  , const bf16_t* VT  , bf16_t* Mix, const float* qg, const float* kg, const float* relb  ) {
    constexpr int KLD = 72, VLD = 72;
    LAS bf16_t* Kt = (LAS bf16_t*)C.lds;
    LAS bf16_t* Vt = Kt + 4 * 64 * KLD;
    LAS float* bias = (LAS float*)(Vt + 4 * 64 * VLD);
    const int w = C.wave, r = C.lane & 31, hh = C.lane >> 5, hw = w >> 1, qb = w & 1;
    for (int u = blockIdx.x; u < BATCH * 32 * 4; u += gridDim.x) {
        int b, c, hg;
        if (gridDim.x == 256) { const int x = u & 7, k = (u >> 3) & 31, it = u >> 8, combo = x * 4 + it; b = combo >> 2; hg = combo & 3; c = (k + 8 * it) & 31; }
        else { b = u >> 7; c = (u >> 2) & 31; hg = u & 3; }
        const int head = hg * 4 + hw;
        __syncthreads();
        for (int i = C.tid; i < 4 * 257; i += NTHR) { const int h4 = i / 257, k = i - h4 * 257; bias[h4 * 260 + k] = relb[(hg * 4 + h4) * 257 + k] * 1.4426950408889634f; }
        const int qrow = b * SEQ + c * 64 + qb * 32 + r;
        bf16x8 qfr[4];
        { float qv[4][8]; float ss = 0.f;
#pragma unroll
          for (int s = 0; s < 4; ++s) { const u32x4 wq = *(const u32x4*)(QKb + (size_t)qrow * 2048 + head * 64 + 16 * s + 8 * hh); unpack8(wq, qv[s]);
#pragma unroll
              for (int j = 0; j < 8; ++j) ss += qv[s][j] * qv[s][j]; }
          ss += __shfl_xor(ss, 32); const float rstd = rsqrtf(ss * (1.f / 64.f) + EPS) * (0.125f * 1.4426950408889634f);
#pragma unroll
          for (int s = 0; s < 4; ++s) { const f32x4 g0 = *(const f32x4*)(qg + 16 * s + 8 * hh), g1 = *(const f32x4*)(qg + 16 * s + 8 * hh + 4);
              qfr[s] = mk8(cvt_pk_bf16(qv[s][0] * rstd * g0[0], qv[s][1] * rstd * g0[1]), cvt_pk_bf16(qv[s][2] * rstd * g0[2], qv[s][3] * rstd * g0[3]),
                           cvt_pk_bf16(qv[s][4] * rstd * g1[0], qv[s][5] * rstd * g1[1]), cvt_pk_bf16(qv[s][6] * rstd * g1[2], qv[s][7] * rstd * g1[3])); } }
        float mrun = -1e30f, lrun = 0.f; f32x16 O0, O1;
#pragma unroll
        for (int i = 0; i < 16; ++i) { O0[i] = 0.f; O1[i] = 0.f; }
        const int c0 = c > 8 ? c - 8 : 0; const int qpos = c * 64 + qb * 32 + r;
        u32x4 pk[4], pv[4];
#define CA_LOAD(kc_) do { _Pragma("unroll") for (int i = 0; i < 4; ++i) { const int pid = C.tid + NTHR * i; const int h4 = pid >> 9, row_ = (pid >> 3) & 63, pc = pid & 7; \
            pk[i] = *(const u32x4*)(QKb + (size_t)(b * SEQ + (kc_) * 64 + row_) * 2048 + 1024 + (hg * 4 + h4) * 64 + pc * 8); \
            pv[i] = *(const u32x4*)(VT + (size_t)((hg * 4 + h4) * 64 + row_) * M + b * SEQ + (kc_) * 64 + pc * 8); } } while (0)
        CA_LOAD(c0);
        for (int kc = c0; kc <= c; ++kc) {
            __syncthreads();
#pragma unroll
            for (int i = 0; i < 4; ++i) { const int pid = C.tid + NTHR * i; const int h4 = pid >> 9, row_ = (pid >> 3) & 63, pc = pid & 7;
                float kv[8]; unpack8(pk[i], kv);
                float ss = 0.f;
#pragma unroll
                for (int j = 0; j < 8; ++j) ss += kv[j] * kv[j];
                ss += __shfl_xor(ss, 1); ss += __shfl_xor(ss, 2); ss += __shfl_xor(ss, 4);
                const float rstd = rsqrtf(ss * (1.f / 64.f) + EPS); const f32x4 g0 = *(const f32x4*)(kg + pc * 8), g1 = *(const f32x4*)(kg + pc * 8 + 4);
                *(LAS u32x4*)(Kt + (h4 * 64 + row_) * KLD + pc * 8) = (u32x4){cvt_pk_bf16(kv[0] * rstd * g0[0], kv[1] * rstd * g0[1]), cvt_pk_bf16(kv[2] * rstd * g0[2], kv[3] * rstd * g0[3]),
                                                                              cvt_pk_bf16(kv[4] * rstd * g1[0], kv[5] * rstd * g1[1]), cvt_pk_bf16(kv[6] * rstd * g1[2], kv[7] * rstd * g1[3])};
                *(LAS u32x4*)(Vt + (h4 * 64 + row_) * VLD + pc * 8) = pv[i]; }
            __syncthreads();
            if (kc < c) CA_LOAD(kc + 1);
#pragma unroll
            for (int sub = 0; sub < 2; ++sub) {
                f32x16 acc;
#pragma unroll
                for (int i = 0; i < 16; ++i) acc[i] = 0.f;
#pragma unroll
                for (int s = 0; s < 4; ++s) { const bf16x8 a = *(const LAS bf16x8*)(Kt + (hw * 64 + sub * 32 + r) * KLD + 16 * s + 8 * hh); acc = MFMA32(a, qfr[s], acc); }
                float mt = -1e30f; const int kbase = kc * 64 + sub * 32;
                if (qpos - (kbase + 31) >= 128) {
                    const float bc = bias[hw * 260 + 256];
#pragma unroll
                    for (int i = 0; i < 16; ++i) { acc[i] += bc; mt = fmaxf(mt, acc[i]); }
                } else {
#pragma unroll
                    for (int i = 0; i < 16; ++i) { const int krow = (i & 3) + 8 * (i >> 2) + 4 * hh; int rel = qpos - (kbase + krow); rel = rel > 128 ? 128 : (rel < -128 ? -128 : rel);
                        acc[i] += bias[hw * 260 + rel + 128]; mt = fmaxf(mt, acc[i]); }
                }
                mt = fmaxf(mt, __shfl_xor(mt, 32));
                const float mnew = fmaxf(mrun, mt), alpha = __builtin_amdgcn_exp2f(mrun - mnew); float ls = 0.f;
#pragma unroll
                for (int i = 0; i < 16; ++i) { acc[i] = __builtin_amdgcn_exp2f(acc[i] - mnew); ls += acc[i]; }
                ls += __shfl_xor(ls, 32); lrun = lrun * alpha + ls; mrun = mnew;
                if (__builtin_amdgcn_ballot_w64(alpha != 1.f) != 0ull) {
#pragma unroll
                    for (int i = 0; i < 16; ++i) { O0[i] *= alpha; O1[i] *= alpha; } }
                const bf16x8 pa0 = mk8(cvt_pk_bf16(acc[0], acc[1]), cvt_pk_bf16(acc[2], acc[3]), cvt_pk_bf16(acc[4], acc[5]), cvt_pk_bf16(acc[6], acc[7]));
                const bf16x8 pa1 = mk8(cvt_pk_bf16(acc[8], acc[9]), cvt_pk_bf16(acc[10], acc[11]), cvt_pk_bf16(acc[12], acc[13]), cvt_pk_bf16(acc[14], acc[15]));
#pragma unroll
                for (int db = 0; db < 2; ++db) {
                    const LAS bf16_t* vrow = Vt + (hw * 64 + db * 32 + r) * VLD + sub * 32;
                    const u32x2 l0 = *(const LAS u32x2*)(vrow + 4 * hh), h0 = *(const LAS u32x2*)(vrow + 8 + 4 * hh), l1 = *(const LAS u32x2*)(vrow + 16 + 4 * hh), h1 = *(const LAS u32x2*)(vrow + 24 + 4 * hh);
                    if (db == 0) { O0 = MFMA32(mk8(l0.x, l0.y, h0.x, h0.y), pa0, O0); O0 = MFMA32(mk8(l1.x, l1.y, h1.x, h1.y), pa1, O0); }
                    else         { O1 = MFMA32(mk8(l0.x, l0.y, h0.x, h0.y), pa0, O1); O1 = MFMA32(mk8(l1.x, l1.y, h1.x, h1.y), pa1, O1); }
                }
            }
        }
#undef CA_LOAD
        const float inv = 1.f / lrun;
        bf16_t* orow = Mix + (size_t)qrow * D + head * 64;
#pragma unroll
        for (int q4 = 0; q4 < 4; ++q4) {
            *(u32x2*)(orow + 8 * q4 + 4 * hh)      = (u32x2){cvt_pk_bf16(O0[4 * q4] * inv, O0[4 * q4 + 1] * inv), cvt_pk_bf16(O0[4 * q4 + 2] * inv, O0[4 * q4 + 3] * inv)};
            *(u32x2*)(orow + 32 + 8 * q4 + 4 * hh) = (u32x2){cvt_pk_bf16(O1[4 * q4] * inv, O1[4 * q4 + 1] * inv), cvt_pk_bf16(O1[4 * q4 + 2] * inv, O1[4 * q4 + 3] * inv)};
        }
    }
    __syncthreads();
}

DI void cross_attn(const Ctx& C, const bf16_t* QX  , const bf16_t* KALL  , const bf16_t* VTALL  , bf16_t* Mix, const float* qg  , int layer) {
    constexpr int KLD = 264, VLD = 40;
    LAS bf16_t* Kt = (LAS bf16_t*)C.lds;
    LAS bf16_t* Vt = Kt + 32 * KLD;
    LAS bf16x8* Qs = (LAS bf16x8*)(Vt + 256 * VLD);
    const int w = C.wave, r = C.lane & 31, hh = C.lane >> 5, qs = w >> 1, dh = w & 1;
    for (int u = blockIdx.x; u < BATCH * 4 * 16; u += gridDim.x) {
        int b, head, qg16;
        if (gridDim.x == 256) { const int x = u & 7, k = (u >> 3) & 31, it = u >> 8, combo = x * 4 + it * 2 + (k >> 4); b = combo >> 2; head = combo & 3; qg16 = k & 15; }
        else { b = u >> 6; head = (u >> 4) & 3; qg16 = u & 15; }
        const int qrow = b * SEQ + qg16 * 128 + qs * 32 + r;
        __syncthreads();
        { float ss = 0.f; const bf16_t* qp = QX + (size_t)qrow * D + head * 256 + 8 * hh;
#pragma unroll
          for (int s = 0; s < 16; ++s) { const u32x4 w4 = *(const u32x4*)(qp + 16 * s); float qv[8]; unpack8(w4, qv);
#pragma unroll
              for (int j = 0; j < 8; ++j) ss += qv[j] * qv[j]; }
          ss += __shfl_xor(ss, 32); const float rstd = rsqrtf(ss * (1.f / 256.f) + EPS) * (0.0625f * 1.4426950408889634f);
#pragma unroll
          for (int s = 0; s < 16; ++s) { const u32x4 w4 = *(const u32x4*)(qp + 16 * s); float qv[8]; unpack8(w4, qv); const f32x4 g0 = *(const f32x4*)(qg + 16 * s + 8 * hh), g1 = *(const f32x4*)(qg + 16 * s + 8 * hh + 4);
              const bf16x8 fr = mk8(cvt_pk_bf16(qv[0] * rstd * g0[0], qv[1] * rstd * g0[1]), cvt_pk_bf16(qv[2] * rstd * g0[2], qv[3] * rstd * g0[3]),
                           cvt_pk_bf16(qv[4] * rstd * g1[0], qv[5] * rstd * g1[1]), cvt_pk_bf16(qv[6] * rstd * g1[2], qv[7] * rstd * g1[3]));
              if (dh == 0) Qs[(qs * 16 + s) * 64 + C.lane] = fr; } }
        float mrun = -1e30f, lrun = 0.f; f32x16 O[4];
#pragma unroll
        for (int db = 0; db < 4; ++db)
#pragma unroll
            for (int i = 0; i < 16; ++i) O[db][i] = 0.f;
        u32x4 pk[2], pv[2];
#define XA_LOAD(kt_) do { _Pragma("unroll") for (int i = 0; i < 2; ++i) { const int pid = C.tid + NTHR * i; \
            { const int key = pid >> 5, pc = pid & 31; pk[i] = *(const u32x4*)(KALL + (size_t)(b * NMEM + (kt_) * 32 + key) * 4096 + layer * 1024 + head * 256 + pc * 8); } \
            { const int d = pid >> 2, pc = pid & 3; pv[i] = *(const u32x4*)(VTALL + (size_t)(layer * 1024 + head * 256 + d) * MMEM + b * NMEM + (kt_) * 32 + pc * 8); } } } while (0)
        XA_LOAD(0);
        for (int kt = 0; kt < 8; ++kt) {
            __syncthreads();
#pragma unroll
            for (int i = 0; i < 2; ++i) { const int pid = C.tid + NTHR * i; { const int key = pid >> 5, pc = pid & 31; *(LAS u32x4*)(Kt + key * KLD + pc * 8) = pk[i]; }
                { const int d = pid >> 2, pc = pid & 3; *(LAS u32x4*)(Vt + d * VLD + pc * 8) = pv[i]; } }
            __syncthreads();
            if (kt < 7) XA_LOAD(kt + 1);
            f32x16 acc;
#pragma unroll
            for (int i = 0; i < 16; ++i) acc[i] = 0.f;
#pragma unroll
            for (int s = 0; s < 16; ++s) { const bf16x8 a = *(const LAS bf16x8*)(Kt + r * KLD + 16 * s + 8 * hh); acc = MFMA32(a, Qs[(qs * 16 + s) * 64 + C.lane], acc); }
            float mt = -1e30f;
#pragma unroll
            for (int i = 0; i < 16; ++i) mt = fmaxf(mt, acc[i]);
            mt = fmaxf(mt, __shfl_xor(mt, 32));
            const float mnew = fmaxf(mrun, mt), alpha = __builtin_amdgcn_exp2f(mrun - mnew); float ls = 0.f;
#pragma unroll
            for (int i = 0; i < 16; ++i) { acc[i] = __builtin_amdgcn_exp2f(acc[i] - mnew); ls += acc[i]; }
            const bool resc = __builtin_amdgcn_ballot_w64(alpha != 1.f) != 0ull;
            ls += __shfl_xor(ls, 32); lrun = lrun * alpha + ls; mrun = mnew;
            const bf16x8 pa0 = mk8(cvt_pk_bf16(acc[0], acc[1]), cvt_pk_bf16(acc[2], acc[3]), cvt_pk_bf16(acc[4], acc[5]), cvt_pk_bf16(acc[6], acc[7]));
            const bf16x8 pa1 = mk8(cvt_pk_bf16(acc[8], acc[9]), cvt_pk_bf16(acc[10], acc[11]), cvt_pk_bf16(acc[12], acc[13]), cvt_pk_bf16(acc[14], acc[15]));
#pragma unroll
            for (int db = 0; db < 4; ++db) {
                if (resc) {
#pragma unroll
                    for (int i = 0; i < 16; ++i) O[db][i] *= alpha; }
                const LAS bf16_t* vrow = Vt + (dh * 128 + db * 32 + r) * VLD;
                const u32x2 l0 = *(const LAS u32x2*)(vrow + 4 * hh), h0 = *(const LAS u32x2*)(vrow + 8 + 4 * hh), l1 = *(const LAS u32x2*)(vrow + 16 + 4 * hh), h1 = *(const LAS u32x2*)(vrow + 24 + 4 * hh);
                O[db] = MFMA32(mk8(l0.x, l0.y, h0.x, h0.y), pa0, O[db]); O[db] = MFMA32(mk8(l1.x, l1.y, h1.x, h1.y), pa1, O[db]);
            }
        }
        const float inv = 1.f / lrun;
        bf16_t* orow = Mix + (size_t)qrow * D + head * 256 + dh * 128;
#pragma unroll
        for (int db = 0; db < 4; ++db)
#pragma unroll
            for (int q4 = 0; q4 < 4; ++q4)
                *(u32x2*)(orow + db * 32 + 8 * q4 + 4 * hh) = (u32x2){cvt_pk_bf16(O[db][4 * q4] * inv, O[db][4 * q4 + 1] * inv), cvt_pk_bf16(O[db][4 * q4 + 2] * inv, O[db][4 * q4 + 3] * inv)};
    }
    __syncthreads();
}

#define XB_TMO      128
#define XB_XCNT(j)  (256  + 64 * (j))
#define XB_XSUB(j)  (1280 + 64 * (j))
#define XB_XGEN(j)  (2304 + 64 * (j))
#define XB_TOP      3328
#define XB_TOPGEN   3392
#define XB_SPIN_CAP (1u << 22)
DI unsigned xb_ld(unsigned* p)              { return __hip_atomic_load(p, __ATOMIC_RELAXED, __HIP_MEMORY_SCOPE_AGENT); }
DI unsigned xb_add(unsigned* p, unsigned v) { return __hip_atomic_fetch_add(p, v, __ATOMIC_RELAXED, __HIP_MEMORY_SCOPE_AGENT); }
DI unsigned xb_xcc_id() { return (unsigned)__builtin_amdgcn_s_getreg((3 << 11) | 20) & 0xFu; }
#define XB_SPIN(cond, bar) do { unsigned _sp = 0; while (cond) { __builtin_amdgcn_s_sleep(1); \
    if ((++_sp & 255u) == 0u) { if (xb_ld(&(bar)[XB_TMO])) break; if (_sp > XB_SPIN_CAP) { atomicAdd(&(bar)[XB_TMO], 1u); break; } } } } while (0)
struct XcdBarrier { unsigned* bar; unsigned x; volatile LAS unsigned* st; };
DI XcdBarrier xcd_barrier_post(unsigned* bar, volatile LAS unsigned* st) {
    XcdBarrier b; b.bar = bar; b.x = xb_xcc_id(); b.st = st;
    if (threadIdx.x == 0) (void)xb_add(&bar[XB_XCNT(b.x)], 1u);
    return b;
}
DI void xcd_barrier_complete(unsigned* bar, unsigned x, unsigned& nloc, unsigned& nx) {
    const unsigned G = gridDim.x * gridDim.y * gridDim.z;
    unsigned sum, cnt, mine, sp = 0u;
    for (;;) {
        sum = 0u; cnt = 0u; mine = 0u;
#pragma unroll
        for (unsigned j = 0; j < 16; ++j) { const unsigned c = xb_ld(&bar[XB_XCNT(j)]); sum += c; cnt += (c > 0u) ? 1u : 0u; mine = (j == x) ? c : mine; }
        if (sum == G) break;
        __builtin_amdgcn_s_sleep(1);
        if ((++sp & 255u) == 0u) { if (xb_ld(&bar[XB_TMO])) break; if (sp > XB_SPIN_CAP) { atomicAdd(&bar[XB_TMO], 1u); break; } }
    }
    nloc = mine > 0u ? mine : 1u; nx = cnt > 0u ? cnt : 1u;
}
DI void xcd_barrier(const XcdBarrier& b) {
    asm volatile("s_waitcnt vmcnt(0)" ::: "memory");
    __syncthreads();
    if (threadIdx.x == 0) {
        unsigned* bar = b.bar;
        __builtin_amdgcn_s_waitcnt(0);
        unsigned nloc = b.st[0], nx = b.st[1];
        if (nloc == 0u) { xcd_barrier_complete(bar, b.x, nloc, nx); b.st[0] = nloc; b.st[1] = nx; }
        const unsigned old = xb_add(&bar[XB_XSUB(b.x)], 1u);
        const unsigned gen = old / nloc;
        if (old + 1u == (gen + 1u) * nloc) {
            __builtin_amdgcn_fence(__ATOMIC_RELEASE, "agent");
            asm volatile("s_waitcnt vmcnt(0)" ::: "memory");
            const unsigned og = xb_add(&bar[XB_TOP], 1u);
            const unsigned tg = og / nx;
            if (og + 1u == (tg + 1u) * nx) xb_add(&bar[XB_TOPGEN], 1u);
            else XB_SPIN(xb_ld(&bar[XB_TOPGEN]) == tg, bar);
            __builtin_amdgcn_fence(__ATOMIC_ACQUIRE, "agent");
            xb_add(&bar[XB_XGEN(b.x)], 1u);
            asm volatile("s_waitcnt vmcnt(0)" ::: "memory");
        } else {
            XB_SPIN(xb_ld(&bar[XB_XGEN(b.x)]) == gen, bar);
            __builtin_amdgcn_fence(__ATOMIC_ACQUIRE, "agent");
            asm volatile("s_waitcnt vmcnt(0)" ::: "memory");
        }
    }
    __syncthreads();
}
struct Args { const float* in[36]; float* out; unsigned char* wsp; int ph_lo, ph_hi; };
constexpr int NPHASES = 40;

#define CV_JOB(W_, K_, N_, ldw_, noff_, WT_, rowoff_, grp_, gstride_, gain_) { const int items_ = ((K_) / 64) * (((N_) + 31) / 32); \
        if (r < items_) { tr_item((W_), (K_), (N_), (ldw_), (noff_), (WT_), (rowoff_), (grp_), (gstride_), scr_, r, C.lane, (gain_)); continue; } r -= items_; }
DI void convert_layer(const Ctx& C, const Args& a, int layer) {
    unsigned char* wl_ = a.wsp + ((layer & 1) ? WS_HN : WS_WL); const int i = layer >> 1;
    LAS float* scr_ = (LAS float*)(C.lds + C.wave * 16384);
    constexpr int NO = 1 << 20;
    if ((layer & 1) == 0) {
        constexpr int TOT = 16 * 81 + 16 * 32 + 8 * 16 + 2 * 16 * 32 + 2 * 16 * 88 + 44 * 32;
        for (int it = C.gw; it < TOT; it += C.ngw) { int r = it;
            CV_JOB(a.in[3] + (size_t)i * D * ABIN, D, ABIN, ABIN, 0, (bf16_t*)(wl_ + WL_IN), 0, NO, 0, a.in[2] + i * D)
            CV_JOB(a.in[4] + (size_t)i * D * D, D, D, D, 0, (bf16_t*)(wl_ + WL_OUT), 0, NO, 0, nullptr)
            CV_JOB(a.in[13] + (size_t)i * 512 * 512, 512, 512, 512, 0, (bf16_t*)(wl_ + WL_GLU), 0, NO, 0, nullptr)
            CV_JOB(a.in[27] + (size_t)layer * D * D, D, D, D, 0, (bf16_t*)(wl_ + WL_XQ), 0, NO, 0, a.in[26] + layer * D)
            CV_JOB(a.in[29] + (size_t)layer * D * D, D, D, D, 0, (bf16_t*)(wl_ + WL_XO), 0, NO, 0, nullptr)
            CV_JOB(a.in[33] + (size_t)layer * D * FF, D, FF, FF, 0, (bf16_t*)(wl_ + WL_GU), 0, 128, 256, a.in[32] + layer * D)
            CV_JOB(a.in[34] + (size_t)layer * D * FF, D, FF, FF, 0, (bf16_t*)(wl_ + WL_GU), 128, 128, 256, a.in[32] + layer * D)
            CV_JOB(a.in[35] + (size_t)layer * FF * D, FF, D, D, 0, (bf16_t*)(wl_ + WL_DN), 0, NO, 0, nullptr)
        }
        s5_build(C, a.in[5] + i * 2048, a.in[6] + i * 2048, a.in[7] + i * 32, a.in[8] + (size_t)i * 32768, a.in[9] + (size_t)i * 32768, a.in[10] + (size_t)i * 32768, a.in[11] + (size_t)i * 32768,
                 (bf16_t*)(a.wsp + WS_SCR + SC_T), (bf16_t*)(a.wsp + WS_SCR + SC_BM));
    } else {
        constexpr int TOT = 16 * 64 + 16 * 32 + 16 * 32 + 2 * 16 * 32 + 2 * 16 * 88 + 44 * 32;
        for (int it = C.gw; it < TOT; it += C.ngw) { int r = it;
            CV_JOB(a.in[20] + (size_t)i * D * 3 * D, D, 2 * D, 3 * D, 0, (bf16_t*)(wl_ + WL_IN), 0, NO, 0, a.in[19] + i * D)
            CV_JOB(a.in[20] + (size_t)i * D * 3 * D, D, D, 3 * D, 2 * D, (bf16_t*)(wl_ + WL_V), 0, NO, 0, a.in[19] + i * D)
            CV_JOB(a.in[21] + (size_t)i * D * D, D, D, D, 0, (bf16_t*)(wl_ + WL_OUT), 0, NO, 0, nullptr)
            CV_JOB(a.in[27] + (size_t)layer * D * D, D, D, D, 0, (bf16_t*)(wl_ + WL_XQ), 0, NO, 0, a.in[26] + layer * D)
            CV_JOB(a.in[29] + (size_t)layer * D * D, D, D, D, 0, (bf16_t*)(wl_ + WL_XO), 0, NO, 0, nullptr)
            CV_JOB(a.in[33] + (size_t)layer * D * FF, D, FF, FF, 0, (bf16_t*)(wl_ + WL_GU), 0, 128, 256, a.in[32] + layer * D)
            CV_JOB(a.in[34] + (size_t)layer * D * FF, D, FF, FF, 0, (bf16_t*)(wl_ + WL_GU), 128, 128, 256, a.in[32] + layer * D)
            CV_JOB(a.in[35] + (size_t)layer * FF * D, FF, D, D, 0, (bf16_t*)(wl_ + WL_DN), 0, NO, 0, nullptr)
        }
    }
}

__global__ void __launch_bounds__(NTHR, 2) fwd_kernel(Args a) {
    extern __shared__ __attribute__((aligned(16))) unsigned char lds_raw[];
    LAS unsigned char* lds = (LAS unsigned char*)lds_raw;
#define ws     ws_
#define wl     (ws_ + (((layer_) & 1) ? WS_HN : WS_WL))
#define scr    (ws_ + WS_SCR)
#define PSJ(j) ((float*)(ws_ + WS_PS + (size_t)((j) & 1) * MiB))
#define SSC    ((float*)(ws_ + WS_SS))
#define OUTF   xo_
#define XB     ((bf16_t*)(ws_ + WS_MIX))
#define MIX    ((bf16_t*)xo_)
#define HN     ((bf16_t*)((unsigned char*)xo_ + 32 * MiB))
#define BIG    ((bf16_t*)(ws_ + WS_BIG))
#define LOGITS ((float*)(ws_ + WS_LOG))
#define KALL   ((bf16_t*)(ws_ + WS_KALL))
#define VTALL  ((bf16_t*)(ws_ + WS_VTALL))
#define MEMN   ((bf16_t*)(ws_ + WS_MEMN))
    volatile LAS unsigned* MISC = (volatile LAS unsigned*)(lds + LDS_BYTES - 64);
    if (threadIdx.x < 16) MISC[threadIdx.x] = 0u;
    __syncthreads();
    XcdBarrier xbar; xbar.bar = (unsigned*)a.wsp; xbar.x = 0; xbar.st = nullptr;
    if (a.ph_hi - a.ph_lo > 1) xbar = xcd_barrier_post((unsigned*)a.wsp, MISC);
    const int lo = a.ph_lo, hi = a.ph_hi; int ph = 0;
#define PH_BEGIN if (ph >= lo && ph < hi) { const Ctx C = make_ctx(lds); unsigned char* ws_ = a.wsp; float* xo_ = a.out; int G = gridDim.x, bx = blockIdx.x; \
        asm volatile("" : "+s"(ws_), "+s"(xo_), "+s"(G), "+s"(bx));
#define PH_END   if (ph + 1 < hi) { if (ph == lo) cg::this_grid().sync(); else { xcd_barrier(xbar); if (DBG_DOUBLE & 512) xcd_barrier(xbar); } } } ++ph;
    using namespace pg8;
    PH_BEGIN
        { LAS float* scr_ = (LAS float*)(C.lds + C.wave * 16384);
          for (int it = C.gw; it < 8 * 512; it += C.ngw) { const int job = it >> 9, l = job & 3, isv = job >> 2;
              tr_item(a.in[28] + (size_t)l * D * 2 * D, D, D, 2 * D, isv * D, (bf16_t*)(scr + SC_WKV + (size_t)isv * 8 * MiB), l * 1024, 1 << 20, 0, scr_, it & 511, C.lane); } }
        convert_layer(C, a, 0);
        if (DBG_DOUBLE & 256) convert_layer(C, a, 0);
        rms_rows(C, a.in[1], a.in[25], MEMN, MMEM);
        x_prep(C, a.in[0], XB, PSJ(0));
    PH_END
    PH_BEGIN
        const int half = G / 2; const bool second = bx >= half;
        if (!second) { Gemm g{MEMN, (const bf16_t*)(scr + SC_WKV), D, D, D, 0, 0}; Order S{MMEM / 256, 4096 / 256, 1, half, bx}; EpiStore E{KALL, 4096, 0, nullptr, nullptr}; gemm_phase<EpiStore, true>(lds, g, S, E); }
        else         { Gemm g{(const bf16_t*)(scr + SC_WKV + 8 * MiB), MEMN, D, D, D, 0, 0}; Order S{4096 / 256, MMEM / 256, 1, G - half, bx - half}; EpiStore E{VTALL, MMEM, 0, nullptr, nullptr}; gemm_phase<EpiStore, true>(lds, g, S, E); }
    PH_END
    for (int layer = 0; layer < 4; ++layer) {
        const int layer_ = layer; const int i = layer >> 1, sj = layer * 3;
        if ((layer & 1) == 0) {
            PH_BEGIN
                if (layer == 0) knorm_phase(C, KALL, a.in[31]);
                Gemm g{XB, (const bf16_t*)(wl + WL_IN), D, D, D, 0, 0}; Order S{M / 256, ABPAD / 256, 1, G, bx}; EpiInProj E{(bf16_t*)(scr + SC_UG), BIG, LOGITS, PSJ(sj)}; gemm_phase<EpiInProj, true>(lds, g, S, E);
            PH_END
            PH_BEGIN
                if (bx < 64) { Gemm g{(const bf16_t*)(scr + SC_UG), (const bf16_t*)(scr + SC_BM), S5K, 512, 512, (long)S5ROWS * S5K, 256L * 512}; Order S{2, 1, 32, 64, bx}; EpiS5State E{(float*)(scr + SC_S)}; gemm_phase<EpiS5State, true>(lds, g, S, E); }
                gdn_pre(C, BIG, LOGITS, a.in[15] + (size_t)i * 4 * 1536, a.in[16] + i * 4, a.in[17] + i * 4, scr, (unsigned char*)HN);
                if (DBG_DOUBLE & 4) gdn_pre(C, BIG, LOGITS, a.in[15] + (size_t)i * 4 * 1536, a.in[16] + i * 4, a.in[17] + i * 4, scr, (unsigned char*)HN);
            PH_END
            PH_BEGIN
                s5_scan(C, a.in[5] + i * 2048, a.in[6] + i * 2048, a.in[7] + i * 32, (const float*)(scr + SC_S), (bf16_t*)(scr + SC_UG));
                gdn_seq(C, scr, (const unsigned char*)HN, (float*)MIX);
            PH_END
            PH_BEGIN
                const int half = G / 2;
                if (bx < half) { Gemm g{(const bf16_t*)(scr + SC_UG), (const bf16_t*)(scr + SC_T), S5K, S5K, S5K, (long)S5ROWS * S5K, 512L * S5K}; Order S{2, 2, 32, half, bx}; EpiS5Y E{(const bf16_t*)(scr + SC_UG), a.in[12] + i * 512, BIG}; gemm_phase<EpiS5Y, true>(lds, g, S, E); }
                else { Ctx C2 = C; C2.gw = (bx - half) * NWAVES + C.wave; C2.ngw = (G - half) * NWAVES; gdn_post(C2, (const float*)MIX, BIG, a.in[18] + i * 128, MIX); }
            PH_END
            PH_BEGIN
                Gemm g{BIG, (const bf16_t*)(wl + WL_GLU), ABPAD, 512, 512, 0, 0}; Order S{M / 256, 2, 1, G, bx}; EpiGlu E{BIG, a.in[14] + i * 512, MIX}; gemm_phase<EpiGlu, true>(lds, g, S, E);
            PH_END
            PH_BEGIN
                Gemm g{MIX, (const bf16_t*)(wl + WL_OUT), D, D, D, 0, 0}; Order S{M / 256, 4, 1, G, bx}; EpiResid E{XB, nullptr, PSJ(sj + 1), (LAS float*)(lds + 131072)}; gemm_phase<EpiResid, true>(lds, g, S, E);
            PH_END
        } else {
            PH_BEGIN
                { Gemm g{XB, (const bf16_t*)(wl + WL_IN), D, D, D, 0, 0}; Order S{M / 256, 8, 1, G, bx}; EpiStore E{BIG, 2048, 0, PSJ(sj), nullptr}; gemm_phase<EpiStore, true>(lds, g, S, E); }
                { Gemm g{(const bf16_t*)(wl + WL_V), XB, D, D, D, 0, 0}; Order S{4, M / 256, 1, G, bx}; EpiStore E{BIG + (size_t)M * 2048, M, 0, nullptr, PSJ(sj)}; gemm_phase<EpiStore, true>(lds, g, S, E); }
            PH_END
            PH_BEGIN
                chunk_attn(C, BIG, BIG + (size_t)M * 2048, MIX, a.in[22] + i * 64, a.in[23] + i * 64, a.in[24] + (size_t)i * 16 * 257);
                if (DBG_DOUBLE & 2) { chunk_attn(C, BIG, BIG + (size_t)M * 2048, MIX, a.in[22] + i * 64, a.in[23] + i * 64, a.in[24] + (size_t)i * 16 * 257); }
            PH_END
            PH_BEGIN
                { Gemm g{MIX, (const bf16_t*)(wl + WL_OUT), D, D, D, 0, 0}; Order S{M / 256, 4, 1, G, bx}; EpiResid E{XB, nullptr, PSJ(sj + 1), (LAS float*)(lds + 131072)}; gemm_phase<EpiResid, true>(lds, g, S, E); }
            PH_END
        }
        PH_BEGIN
            Gemm g{XB, (const bf16_t*)(wl + WL_XQ), D, D, D, 0, 0}; Order S{M / 256, 4, 1, G, bx}; EpiStore E{BIG, D, 0, PSJ(sj + 1), nullptr}; gemm_phase<EpiStore, true>(lds, g, S, E);
        PH_END
        PH_BEGIN
            cross_attn(C, BIG, KALL, VTALL, MIX, a.in[30] + layer * 256, layer);
                if (DBG_DOUBLE & 1) { cross_attn(C, BIG, KALL, VTALL, MIX, a.in[30] + layer * 256, layer); }
        PH_END
        PH_BEGIN
            { Gemm g{MIX, (const bf16_t*)(wl + WL_XO), D, D, D, 0, 0}; Order S{M / 256, 4, 1, G, bx}; EpiResid E{XB, nullptr, PSJ(sj + 2), (LAS float*)(lds + 131072)}; gemm_phase<EpiResid, true>(lds, g, S, E); }
        PH_END
        PH_BEGIN
            Gemm g{XB, (const bf16_t*)(wl + WL_GU), D, D, D, 0, 0}; Order S{M / 256, 2 * FF / 256, 1, G, bx}; EpiSwiglu E{BIG, PSJ(sj + 2)}; gemm_phase<EpiSwiglu, true>(lds, g, S, E);
            if (layer < 3 && bx >= G / 2) { Ctx C2 = C; C2.gw = (bx - G / 2) * NWAVES + C.wave; C2.ngw = (G - G / 2) * NWAVES; convert_layer(C2, a, layer + 1); }
        PH_END
        PH_BEGIN
            { Gemm g{BIG, (const bf16_t*)(wl + WL_DN), FF, FF, FF, 0, 0}; Order S{M / 256, 4, 1, G, bx}; EpiResid E{XB, layer == 3 ? OUTF : (float*)nullptr, layer < 3 ? PSJ(sj + 3) : (float*)nullptr, (LAS float*)(lds + 131072)}; gemm_phase<EpiResid, true>(lds, g, S, E); }
        PH_END
    }
#if DBG_CHECK
    if (hi == NPHASES) { cg::this_grid().sync(); if (bx == 0 && threadIdx.x == 0) { const unsigned f = *(volatile unsigned*)ws; if (f != 0x7f7f7f7fu) X[0] = 10000.f * (float)f; } }
#endif
}

extern "C" void kernel_launch(void* const* d_in, const int* in_sizes, int n_in, void* d_out, int out_size, void* d_ws, size_t ws_size, hipStream_t stream) {
    static int grid = 0;
    if (grid == 0) {
        if (n_in != 36 || out_size != M * D || ws_size < WS_END) { fprintf(stderr, "kernel_launch: unexpected problem (n_in %d, out %d, ws %zu)\n", n_in, out_size, ws_size); grid = -1; return; }
        int dev = 0, cus = 0;
        hipGetDevice(&dev); hipDeviceGetAttribute(&cus, hipDeviceAttributeMultiprocessorCount, dev);
        if (hipFuncSetAttribute((const void*)fwd_kernel, hipFuncAttributeMaxDynamicSharedMemorySize, LDS_BYTES) != hipSuccess) { fprintf(stderr, "kernel_launch: hipFuncSetAttribute failed\n"); grid = -1; return; }
        int per_cu = 0;
        if (hipOccupancyMaxActiveBlocksPerMultiprocessor(&per_cu, (const void*)fwd_kernel, NTHR, LDS_BYTES) != hipSuccess || per_cu < 1) { fprintf(stderr, "kernel_launch: occupancy query says %d\n", per_cu); per_cu = 1; }
        (void)hipGetLastError();
        grid = cus > 0 ? cus : 256;
    }
    if (grid < 0) return;
#if DBG_CHECK
    (void)hipMemsetAsync(d_ws, 0x7f, 4, stream);
#endif
    (void)hipMemsetAsync(d_ws, 0, 16384, stream);
    Args a{};
    for (int i = 0; i < 36; ++i) a.in[i] = (const float*)d_in[i];
    a.out = (float*)d_out; a.wsp = (unsigned char*)d_ws;
#if MK_ONE_LAUNCH
    a.ph_lo = 0; a.ph_hi = NPHASES;
    void* args[] = {&a};
    hipError_t e = hipLaunchCooperativeKernel((const void*)fwd_kernel, dim3(grid), dim3(NTHR), args, LDS_BYTES, stream);
    if (e != hipSuccess) fprintf(stderr, "cooperative launch failed: %s (grid %d)\n", hipGetErrorString(e), grid);
#else
    for (int p = 0; p < NPHASES; ++p) {
        a.ph_lo = p; a.ph_hi = p + 1;
        hipLaunchKernelGGL(fwd_kernel, dim3(grid), dim3(NTHR), LDS_BYTES, stream, a);
    }
#endif
}
```
